# Optimizing an MI355X kernel written in HIP

```python
import jax, jax.numpy as jnp
from jax import lax
import numpy as np

D_MODEL = 1024
BATCH = 4
SEQ = 4096
DEPTH = 1

CHUNK = 64
GMLP_BLOCK = 128
A_WIDTH = D_MODEL
A_GROUPS = 8
A_GROUP_DIM = A_WIDTH // A_GROUPS
POOL_WINDOWS = (2, 4, 8, 16)
B_WIDTH = D_MODEL
B_GROUPS = len(POOL_WINDOWS)
B_GROUP_DIM = B_WIDTH // B_GROUPS
IN_WIDTH = 2 * A_WIDTH + B_WIDTH
D_FF = ((8 * D_MODEL // 3) + 127) // 128 * 128
CONV_WIDTH = 3
N_ADA = 6
EPS = 1e-6

kernel_name = "chunk_causal_gmlp_pool_hybrid_adaln"


def rmsnorm(x, g):
    xf = x.astype(jnp.float32)
    y = xf * lax.rsqrt(jnp.mean(xf * xf, axis=-1, keepdims=True) + EPS)
    return (y * g.astype(jnp.float32)).astype(x.dtype)


def layernorm(x, g, b):
    xf = x.astype(jnp.float32)
    mu = jnp.mean(xf, axis=-1, keepdims=True)
    var = jnp.mean(jnp.square(xf - mu), axis=-1, keepdims=True)
    y = (xf - mu) * lax.rsqrt(var + EPS)
    return (y * g.astype(jnp.float32) + b.astype(jnp.float32)).astype(x.dtype)


def chunk_causal_block_mask():
    p = jnp.arange(GMLP_BLOCK)
    return (p[None, :] // CHUNK) <= (p[:, None] // CHUNK)


def spatial_gating(v, w_s, b_s):
    bsz, s_len, _ = v.shape
    vb = v.reshape(bsz, s_len // GMLP_BLOCK, GMLP_BLOCK, A_GROUPS, A_GROUP_DIM)
    w = jnp.where(chunk_causal_block_mask()[None], w_s, jnp.zeros((), w_s.dtype))
    s = jnp.einsum('gpq,bnqgd->bnpgd', w, vb) + b_s.T[None, None, :, :, None]
    return s.reshape(bsz, s_len, A_WIDTH)


def multiscale_pool(hb, w_pool, b_pool, scale):
    bsz, s_len, _ = hb.shape
    hf = hb.astype(jnp.float32).reshape(bsz, s_len, B_GROUPS, B_GROUP_DIM)
    cs = jnp.cumsum(hf, axis=1)
    t = jnp.arange(s_len)
    outs = []
    for gi, w in enumerate(POOL_WINDOWS):
        csg = cs[:, :, gi]
        lo = jnp.pad(csg[:, :s_len - w], ((0, 0), (w, 0), (0, 0)))
        count = jnp.minimum(t + 1, w).astype(jnp.float32)
        mean = (csg - lo) / count[None, :, None]
        outs.append(mean - hf[:, :, gi])
    pooled = jnp.stack(outs, axis=2)
    mixed = jnp.einsum('bsgc,gcd->bsgd', pooled, w_pool.astype(jnp.float32)) + b_pool.astype(jnp.float32)
    y = mixed.reshape(bsz, s_len, B_WIDTH) * scale.astype(jnp.float32)
    return y.astype(hb.dtype)


def causal_dwconv(z, w, b):
    s_len = z.shape[1]
    zp = jnp.pad(z, ((0, 0), (CONV_WIDTH - 1, 0), (0, 0)))
    out = b
    for k in range(CONV_WIDTH):
        out = out + zp[:, k:k + s_len] * w[k]
    return out


def setup_inputs(seed: int = 0) -> dict:
    key = jax.random.key(seed)
    ks = jax.random.split(key, 24)
    L, D = DEPTH, D_MODEL
    f32 = jnp.float32

    def nrm(k, shape, s):
        return jax.random.normal(k, shape, f32) * s

    return {
        "x": jax.random.normal(ks[0], (BATCH, SEQ, D), f32),
        "c": jax.random.normal(ks[1], (BATCH, D), f32),
        "w_ada": nrm(ks[2], (L, D, N_ADA * D), 0.5 * D ** -0.5),
        "b_ada": nrm(ks[3], (L, N_ADA * D), 0.02),
        "g_norm1": 1.0 + nrm(ks[4], (L, D), 0.05),
        "w_in": nrm(ks[5], (L, D, IN_WIDTH), D ** -0.5),
        "ln_v_g": 1.0 + nrm(ks[6], (L, A_WIDTH), 0.05),
        "ln_v_b": nrm(ks[7], (L, A_WIDTH), 0.02),
        "w_spatial": nrm(ks[8], (L, A_GROUPS, GMLP_BLOCK, GMLP_BLOCK), GMLP_BLOCK ** -0.5),
        "b_spatial": 1.0 + nrm(ks[9], (L, A_GROUPS, GMLP_BLOCK), 0.05),
        "w_pool": nrm(ks[10], (L, B_GROUPS, B_GROUP_DIM, B_GROUP_DIM), B_GROUP_DIM ** -0.5),
        "b_pool": nrm(ks[11], (L, B_GROUPS, B_GROUP_DIM), 0.02),
        "pool_scale": 1.0 + nrm(ks[12], (L, B_WIDTH), 0.05),
        "w_proj_a": nrm(ks[13], (L, A_WIDTH, D), A_WIDTH ** -0.5),
        "w_proj_b": nrm(ks[14], (L, B_WIDTH, D), B_WIDTH ** -0.5),
        "w_gate": nrm(ks[15], (L, D, 2 * D), D ** -0.5),
        "b_gate": nrm(ks[16], (L, 2 * D), 0.02),
        "w_out": nrm(ks[17], (L, D, D), D ** -0.5),
        "g_norm2": 1.0 + nrm(ks[18], (L, D), 0.05),
        "w_up": nrm(ks[19], (L, D, 2 * D_FF), D ** -0.5),
        "conv_w": nrm(ks[20], (L, CONV_WIDTH, 2 * D_FF), CONV_WIDTH ** -0.5),
        "conv_b": nrm(ks[21], (L, 2 * D_FF), 0.02),
        "w_down": nrm(ks[22], (L, D_FF, D), D_FF ** -0.5),
        "g_final": 1.0 + nrm(ks[23], (D,), 0.05),
    }


def reference(x, c, w_ada, b_ada, g_norm1, w_in, ln_v_g, ln_v_b, w_spatial, b_spatial,
              w_pool, b_pool, pool_scale, w_proj_a, w_proj_b, w_gate, b_gate, w_out,
              g_norm2, w_up, conv_w, conv_b, w_down, g_final):
    for l in range(DEPTH):
        mod = jax.nn.silu(c) @ w_ada[l] + b_ada[l]
        sh1, sc1, gt1, sh2, sc2, gt2 = [m[:, None, :] for m in jnp.split(mod, N_ADA, axis=-1)]

        h = rmsnorm(x, g_norm1[l]) * (1.0 + sc1) + sh1
        z = h @ w_in[l]
        za = jax.nn.gelu(z[..., :2 * A_WIDTH], approximate=False)
        u, v = za[..., :A_WIDTH], za[..., A_WIDTH:]
        v = layernorm(v, ln_v_g[l], ln_v_b[l])
        y_a = u * spatial_gating(v, w_spatial[l], b_spatial[l])
        y_b = multiscale_pool(z[..., 2 * A_WIDTH:], w_pool[l], b_pool[l], pool_scale[l])
        gates = jax.nn.sigmoid(h @ w_gate[l] + b_gate[l])
        g_a, g_b = gates[..., :D_MODEL], gates[..., D_MODEL:]
        merged = g_a * (y_a @ w_proj_a[l]) + g_b * (y_b @ w_proj_b[l])
        x = x + gt1 * (merged @ w_out[l])

        h2 = rmsnorm(x, g_norm2[l]) * (1.0 + sc2) + sh2
        up = causal_dwconv(h2 @ w_up[l], conv_w[l], conv_b[l])
        f = jax.nn.silu(up[..., :D_FF]) * up[..., D_FF:]
        x = x + gt2 * (f @ w_down[l])
    return rmsnorm(x, g_final)
```

```cpp
#include <hip/hip_runtime.h>
#include <hip/hip_cooperative_groups.h>
#include <cstdio>
#include <cstdint>
namespace cg = cooperative_groups;

#define LAS __attribute__((address_space(3)))
typedef unsigned short bf16_t;
typedef short bf16x8 __attribute__((ext_vector_type(8)));
typedef float f32x4 __attribute__((ext_vector_type(4)));
typedef float f32x2 __attribute__((ext_vector_type(2)));
typedef unsigned u32x4 __attribute__((ext_vector_type(4)));
typedef unsigned u32x2 __attribute__((ext_vector_type(2)));

constexpr int D = 1024, BATCH = 4, SEQ = 4096, M = BATCH * SEQ, DFF = 2816, NUP = 2 * DFF, NADA = 6 * D;
constexpr int N1 = 3 * D + 2 * D;
constexpr float EPS = 1e-6f;
constexpr int MT4 = 254, NM4 = 65;

constexpr size_t MiB = 1u << 20;
constexpr size_t WS_MOD = 0;
constexpr size_t WS_CB = 128 * 1024;
constexpr size_t WS_CW = 512 * 1024;
constexpr size_t WS_VST = 1 * MiB;
constexpr size_t WS_SS2 = 3 * MiB;
constexpr size_t WS_SS3 = 4 * MiB;
constexpr size_t WS_WSP = 5 * MiB;
constexpr size_t WS_WPOOL = 5 * MiB + 512 * 1024;
constexpr size_t WS_W1T = 6 * MiB;
constexpr size_t WS_WPA = 16 * MiB, WS_WPB = 18 * MiB, WS_WOUT = 20 * MiB;
constexpr size_t WS_WUP = 22 * MiB;
constexpr size_t WS_WDN = 33 * MiB;
constexpr size_t WS_H = 40 * MiB;
constexpr size_t WS_U = 72 * MiB;
constexpr size_t WS_V = 104 * MiB;
constexpr size_t WS_ZB = 136 * MiB;
constexpr size_t WS_G = 168 * MiB;
constexpr size_t WS_CTL = 240 * MiB, CTL_BYTES = 64 * 1024;
constexpr size_t WS_F = 72 * MiB;

constexpr int LDS_HALO = 131072;
constexpr int LDS_BYTES = 147456;

__device__ __forceinline__ unsigned cvt_pk_bf16(float lo, float hi) { unsigned r; asm("v_cvt_pk_bf16_f32 %0, %1, %2" : "=v"(r) : "v"(lo), "v"(hi)); return r; }
__device__ __forceinline__ float bf_lo(unsigned w) { return __uint_as_float(w << 16); }
__device__ __forceinline__ float bf_hi(unsigned w) { return __uint_as_float(w & 0xffff0000u); }
__device__ __forceinline__ float wave_sum(float v) {
#pragma unroll
    for (int o = 1; o < 64; o <<= 1) v += __shfl_xor(v, o);
    return v;
}
__device__ __forceinline__ int tid_opaque() { int t = threadIdx.x; asm volatile("" : "+v"(t)); return t; }
__device__ __forceinline__ float sigmoid_f(float x) { return __builtin_amdgcn_rcpf(1.0f + __builtin_amdgcn_exp2f(-1.4426950408889634f * x)); }
__device__ __forceinline__ f32x2 gelu_pk(f32x2 v) {
    const f32x2 av = __builtin_elementwise_abs(v), d = av * 0.2316418882f + 1.0f;
    f32x2 t; t.x = __builtin_amdgcn_rcpf(d.x); t.y = __builtin_amdgcn_rcpf(d.y);
    f32x2 q = t * 0.5307027145f + (-0.7265760135f); q = q * t + 0.7107068705f; q = q * t + (-0.142248368f); q = q * t + 0.127414796f; q = q * t;
    const f32x2 s = (v * v) * (-0.72134752044f);
    f32x2 e; e.x = __builtin_amdgcn_exp2f(s.x); e.y = __builtin_amdgcn_exp2f(s.y);
    const f32x2 m = v * (q * e), r = v - m;
    f32x2 o; o.x = v.x < 0.f ? m.x : r.x; o.y = v.y < 0.f ? m.y : r.y; return o;
}
__device__ __forceinline__ f32x4 gelu4(f32x4 v) { f32x2 a = gelu_pk((f32x2){v[0], v[1]}), b = gelu_pk((f32x2){v[2], v[3]}); return (f32x4){a.x, a.y, b.x, b.y}; }

namespace pg8 {
constexpr int BM = 256, BK = 64, HALF = 128, HTB = HALF * BK * 2, STAGE_BYTES = 8 * HTB, NXCD = 8, WGM = 2;
__host__ __device__ __forceinline__ int lds_byte(int r, int c) { const int st = (r >> 4) * 2 + (c >> 5), rr = r & 15, cc = c & 31, ob = rr * 64 + cc * 2; return st * 1024 + (ob ^ (((ob >> 9) & 1) << 5)); }
__host__ __device__ __forceinline__ void stage_rc(int b, int& R, int& C) { const int st = b / 1024, sb = b % 1024, swz = sb ^ (((sb >> 9) & 1) << 5); R = (st >> 1) * 16 + swz / 64; C = (st & 1) * 32 + (swz % 64) / 2; }
__host__ __device__ __forceinline__ int perm32(int rho) { const int n = rho >> 4, i = rho & 15; return 8 * (i >> 2) + 4 * n + (i & 3); }

struct Unit { int pm, pn, z, ord; };
struct Gemm { const bf16_t* A0; const bf16_t* A1; const bf16_t* B0; const bf16_t* B1; int K; int mstride; };

struct TileOrder {
    int nM, nN, nwg, G, c, ZS;
    __device__ void init(int nM_, int nN_, int G_, int c_, int ZS_) { nM = nM_; nN = nN_; nwg = nM * nN; G = G_; c = c_; ZS = ZS_; }
    __device__ bool next(int i, Unit& u) const {
        const int ti = i >> ZS; u.z = i & ((1 << ZS) - 1); u.ord = i;
        const long L = (long)ti * G + c; if (L >= nwg) return false;
        int wgid = (int)L; { const int q = nwg / NXCD, r = nwg % NXCD, xcd = wgid % NXCD, off = wgid / NXCD; wgid = (xcd < r ? xcd * (q + 1) : r * (q + 1) + (xcd - r) * q) + off; }
        const int nig = WGM * nN, gid = wgid / nig, fm = gid * WGM, gsz = (nM - fm) < WGM ? (nM - fm) : WGM;
        u.pm = fm + ((wgid % nig) % gsz); u.pn = (wgid % nig) / gsz; return true;
    }
};

template <class Epi, class Sched>
__device__ __forceinline__ void gemm_phase(LAS unsigned char* lds, const Gemm g, const Sched& S, const Epi& E) {
    const int tid = tid_opaque(), wid = __builtin_amdgcn_readfirstlane(tid >> 6), lane = tid & 63, wr = wid >> 2, wc = wid & 3, fr = lane & 15, fq = lane >> 4;
    const int K = g.K, nt = K / BK;
    unsigned voffA[2], voffB[2];
#pragma unroll
    for (int i = 0; i < 2; ++i) { int R, C; stage_rc(tid * 16 + i * 8192, R, C); const int Rb = Epi::PERM ? ((R & ~31) + perm32(R & 31)) : R;
        const int Ra = Epi::APERM ? ((R & ~63) + 4 * (R & 15) + ((R & 63) >> 4)) : R;
        voffA[i] = (unsigned)(Ra * K + C) * 2u; voffB[i] = (unsigned)(Rb * K + C) * 2u; }
    const size_t kstep = (size_t)(BK * 2);
    const size_t hstep = (size_t)HALF * K * 2;
    const size_t tstepB = 2 * hstep;
    const size_t tstepA = (size_t)g.mstride * K * 2;
    const unsigned ldsw = (unsigned)wid * 1024u;
    const int aoff = lds_byte(wr * 64 + fr, fq * 8), boff = lds_byte(wc * 32 + fr, fq * 8);
#define PG8_SA(b, h) (((b) * 2 + (h)) * HTB)
#define PG8_SB(b, h) ((4 + (b) * 2 + (h)) * HTB)
#define PG8_STAGE(bufoff, gbase, voff) do { _Pragma("unroll") for (int _i = 0; _i < 2; ++_i) \
        __builtin_amdgcn_global_load_lds((const unsigned*)((const char*)(gbase) + (voff)[_i]), (LAS unsigned*)(lds + (bufoff) + ldsw + _i * 8192), 16, 0, 0); } while (0)
#define PG8_LDA(dst, b, h) do { _Pragma("unroll") for (int m = 0; m < 4; ++m) _Pragma("unroll") for (int k = 0; k < 2; ++k) dst[m][k] = *(const LAS bf16x8*)(lds + PG8_SA(b, h) + aoff + m * 2048 + k * 1024); } while (0)
#define PG8_LDB(dst, b, h) do { _Pragma("unroll") for (int n = 0; n < 2; ++n) _Pragma("unroll") for (int k = 0; k < 2; ++k) dst[n][k] = *(const LAS bf16x8*)(lds + PG8_SB(b, h) + boff + n * 2048 + k * 1024); } while (0)
#define PG8_MMA(ai, bj, At, Bt) do { __builtin_amdgcn_s_setprio(1); _Pragma("unroll") for (int m = 0; m < 4; ++m) _Pragma("unroll") for (int n = 0; n < 2; ++n) _Pragma("unroll") for (int k = 0; k < 2; ++k) \
        acc[ai][bj][m][n] = __builtin_amdgcn_mfma_f32_16x16x32_bf16(Bt[n][k], At[m][k], acc[ai][bj][m][n], 0, 0, 0); __builtin_amdgcn_s_setprio(0); } while (0)
#define PG8_WAIT_V(n) asm volatile("s_waitcnt vmcnt(" #n ")" ::: "memory")
#define PG8_WAIT_L(n) asm volatile("s_waitcnt lgkmcnt(" #n ")" ::: "memory")
#define PG8_BAR __builtin_amdgcn_s_barrier()
#define PG8_SCHED __builtin_amdgcn_sched_barrier(0)
    Unit cur, nxt; int ui = 0;
    if (!S.next(0, cur)) return;
    f32x4 acc[2][2][4][2];
#pragma unroll
    for (int a = 0; a < 2; ++a)
#pragma unroll
        for (int b = 0; b < 2; ++b)
#pragma unroll
            for (int m = 0; m < 4; ++m)
#pragma unroll
                for (int n = 0; n < 2; ++n) acc[a][b][m][n] = (f32x4){0.f, 0.f, 0.f, 0.f};
    bf16x8 At[4][2], B0[2][2], B1[2][2];
    const char* cA = (const char*)(cur.z ? g.A1 : g.A0) + (size_t)cur.pm * tstepA; const char* cB = (const char*)(cur.z ? g.B1 : g.B0) + (size_t)cur.pn * tstepB;
    PG8_STAGE(PG8_SB(0, 0), cB, voffB); PG8_STAGE(PG8_SB(0, 1), cB + hstep, voffB); PG8_STAGE(PG8_SA(0, 0), cA, voffA); PG8_STAGE(PG8_SA(0, 1), cA + hstep, voffA);
    if (wr == 1) PG8_BAR;
    PG8_WAIT_V(2); PG8_BAR;
    PG8_STAGE(PG8_SB(1, 0), cB + kstep, voffB); PG8_STAGE(PG8_SA(1, 0), cA + kstep, voffA); PG8_STAGE(PG8_SB(1, 1), cB + hstep + kstep, voffB);
    PG8_WAIT_V(6); PG8_BAR;
    for (;;) {
        const bool has_next = S.next(ui + 1, nxt);
        const char* nA = has_next ? (const char*)(nxt.z ? g.A1 : g.A0) + (size_t)nxt.pm * tstepA : cA; const char* nB = has_next ? (const char*)(nxt.z ? g.B1 : g.B0) + (size_t)nxt.pn * tstepB : cB;
        for (int t = 0; t < nt; t += 2) {
            const bool last = (t == nt - 2);
            const char* a1 = cA + (size_t)(t + 1) * kstep;
            const char* a2 = last ? nA : cA + (size_t)(t + 2) * kstep; const char* b2 = last ? nB : cB + (size_t)(t + 2) * kstep;
            const char* a3 = a2 + kstep; const char* b3 = b2 + kstep;
            PG8_LDB(B0, 0, 0); PG8_LDB(B1, 0, 1); PG8_SCHED; PG8_LDA(At, 0, 0); PG8_STAGE(PG8_SA(1, 1), a1 + hstep, voffA);
            PG8_WAIT_V(8); PG8_WAIT_L(0); PG8_BAR; PG8_MMA(0, 0, At, B0); PG8_MMA(0, 1, At, B1); PG8_BAR; PG8_SCHED;
            PG8_LDA(At, 0, 1); PG8_STAGE(PG8_SB(0, 0), b2, voffB); PG8_STAGE(PG8_SB(0, 1), b2 + hstep, voffB); PG8_STAGE(PG8_SA(0, 0), a2, voffA);
            PG8_WAIT_V(8); PG8_WAIT_L(0); PG8_BAR; PG8_MMA(1, 0, At, B0); PG8_MMA(1, 1, At, B1); PG8_BAR; PG8_SCHED;
            PG8_LDB(B0, 1, 0); PG8_LDB(B1, 1, 1); PG8_SCHED; PG8_LDA(At, 1, 0); PG8_STAGE(PG8_SA(0, 1), a2 + hstep, voffA);
            PG8_WAIT_V(8); PG8_WAIT_L(0); PG8_BAR; PG8_MMA(0, 0, At, B0); PG8_MMA(0, 1, At, B1); PG8_BAR; PG8_SCHED;
            PG8_LDA(At, 1, 1); PG8_STAGE(PG8_SB(1, 0), b3, voffB); PG8_STAGE(PG8_SB(1, 1), b3 + hstep, voffB); PG8_STAGE(PG8_SA(1, 0), a3, voffA);
            PG8_WAIT_V(8); PG8_WAIT_L(0); PG8_BAR; PG8_MMA(1, 0, At, B0); PG8_MMA(1, 1, At, B1); PG8_BAR; PG8_SCHED;
        }
        if (wr == 0) PG8_BAR;
        E(acc, cur, wr, wc, fr, fq, lds);
        if (!has_next) break;
        if (!E.keep(cur)) {
#pragma unroll
        for (int a = 0; a < 2; ++a)
#pragma unroll
            for (int b = 0; b < 2; ++b)
#pragma unroll
                for (int m = 0; m < 4; ++m)
#pragma unroll
                    for (int n = 0; n < 2; ++n) acc[a][b][m][n] = (f32x4){0.f, 0.f, 0.f, 0.f};
        }
        cur = nxt; cA = nA; cB = nB; ++ui;
        if (wr == 1) PG8_BAR;
    }
    PG8_WAIT_V(0);
    PG8_BAR;
#undef PG8_SA
#undef PG8_SB
#undef PG8_STAGE
#undef PG8_LDA
#undef PG8_LDB
#undef PG8_MMA
#undef PG8_WAIT_V
#undef PG8_WAIT_L
#undef PG8_BAR
#undef PG8_SCHED
}
}
using pg8::Unit;

struct Epi1 {
    static constexpr bool PERM = true, APERM = false;
    bf16_t *U, *V, *ZB, *G; const float* bgate; float* vst;
    __device__ __forceinline__ bool keep(const Unit&) const { return false; }
    __device__ __forceinline__ void operator()(f32x4 (&acc)[2][2][4][2], const Unit& u, int wr, int wc, int fr, int fq, LAS unsigned char*) const {
        const int seg = u.pn >> 2;
        const int row0 = u.pm * 256 + wr * 64 + fr;
        bf16_t* base; int ld, colt;
        if (seg == 0) { base = U; ld = D; colt = u.pn * 256; }
        else if (seg == 1) { base = V; ld = D; colt = (u.pn - 4) * 256; }
        else if (seg == 2) { base = ZB; ld = D; colt = (u.pn - 8) * 256; }
        else { base = G; ld = 2 * D; colt = (u.pn - 12) * 256; }
        const int col0 = colt + wc * 32 + 8 * fq;
        f32x4 bv[2][2];
#pragma unroll
        for (int bj = 0; bj < 2; ++bj)
#pragma unroll
            for (int n = 0; n < 2; ++n) bv[bj][n] = (seg >= 3) ? *(const f32x4*)(bgate + col0 + bj * 128 + 4 * n) : (f32x4){0.f, 0.f, 0.f, 0.f};
#pragma unroll
        for (int ai = 0; ai < 2; ++ai)
#pragma unroll
            for (int m = 0; m < 4; ++m) {
                const int row = row0 + ai * 128 + m * 16;
                bf16_t* rowp = base + (size_t)row * ld + col0;
                float s = 0.f, q = 0.f;
#pragma unroll
                for (int bj = 0; bj < 2; ++bj) {
                    f32x4 v0 = acc[ai][bj][m][0] + bv[bj][0], v1 = acc[ai][bj][m][1] + bv[bj][1];
                    if (seg <= 1) { v0 = gelu4(v0); v1 = gelu4(v1); }
                    else if (seg >= 3) {
#pragma unroll
                        for (int j = 0; j < 4; ++j) { v0[j] = sigmoid_f(v0[j]); v1[j] = sigmoid_f(v1[j]); }
                    }
                    if (seg == 1) {
#pragma unroll
                        for (int j = 0; j < 4; ++j) { s += v0[j] + v1[j]; q += v0[j] * v0[j] + v1[j] * v1[j]; }
                    }
                    u32x4 w; w.x = cvt_pk_bf16(v0[0], v0[1]); w.y = cvt_pk_bf16(v0[2], v0[3]); w.z = cvt_pk_bf16(v1[0], v1[1]); w.w = cvt_pk_bf16(v1[2], v1[3]);
                    *(u32x4*)(rowp + bj * 128) = w;
                }
                if (seg == 1) {
                    s += __shfl_xor(s, 16); s += __shfl_xor(s, 32); q += __shfl_xor(q, 16); q += __shfl_xor(q, 32);
                    if (fq == 0) *(f32x2*)(vst + ((size_t)row * 16 + (u.pn - 4) * 4 + wc) * 2) = (f32x2){s, q};
                }
            }
    }
};
struct Epi2 {
    static constexpr bool PERM = true, APERM = false;
    const bf16_t* G; bf16_t* O;
    __device__ __forceinline__ bool keep(const Unit& u) const { return u.z == 0; }
    __device__ __forceinline__ void operator()(f32x4 (&acc)[2][2][4][2], const Unit& u, int wr, int wc, int fr, int fq, LAS unsigned char*) const {
        const int row0 = u.pm * 256 + wr * 64 + fr, col0 = u.pn * 256 + wc * 32 + 8 * fq;
        if (u.z == 0) {
#pragma unroll
            for (int ai = 0; ai < 2; ++ai)
#pragma unroll
                for (int m = 0; m < 4; ++m) {
                    const bf16_t* gp = G + (size_t)(row0 + ai * 128 + m * 16) * (2 * D) + col0;
#pragma unroll
                    for (int bj = 0; bj < 2; ++bj) {
                        const u32x4 ga4 = *(const u32x4*)(gp + bj * 128), gb4 = *(const u32x4*)(gp + D + bj * 128);
#pragma unroll
                        for (int n = 0; n < 2; ++n) {
                            const unsigned gax = n ? ga4.z : ga4.x, gay = n ? ga4.w : ga4.y, gbx = n ? gb4.z : gb4.x, gby = n ? gb4.w : gb4.y;
                            f32x4 r;
                            r[0] = bf_lo(gax) * __builtin_amdgcn_rcpf(fmaxf(bf_lo(gbx), 1e-30f)); r[1] = bf_hi(gax) * __builtin_amdgcn_rcpf(fmaxf(bf_hi(gbx), 1e-30f));
                            r[2] = bf_lo(gay) * __builtin_amdgcn_rcpf(fmaxf(bf_lo(gby), 1e-30f)); r[3] = bf_hi(gay) * __builtin_amdgcn_rcpf(fmaxf(bf_hi(gby), 1e-30f));
                            acc[ai][bj][m][n] *= r;
                        }
                    }
                    if (m & 1) asm volatile("" ::: "memory");
                }
        } else {
#pragma unroll
            for (int ai = 0; ai < 2; ++ai)
#pragma unroll
                for (int m = 0; m < 4; ++m) {
                    const size_t row = (size_t)(row0 + ai * 128 + m * 16);
                    const bf16_t* gp = G + row * (2 * D) + D + col0;
#pragma unroll
                    for (int bj = 0; bj < 2; ++bj) {
                        const u32x4 gb = *(const u32x4*)(gp + bj * 128);
                        const f32x4 a0 = acc[ai][bj][m][0], a1 = acc[ai][bj][m][1];
                        u32x4 w;
                        w.x = cvt_pk_bf16(a0[0] * fmaxf(bf_lo(gb.x), 1e-30f), a0[1] * fmaxf(bf_hi(gb.x), 1e-30f));
                        w.y = cvt_pk_bf16(a0[2] * fmaxf(bf_lo(gb.y), 1e-30f), a0[3] * fmaxf(bf_hi(gb.y), 1e-30f));
                        w.z = cvt_pk_bf16(a1[0] * fmaxf(bf_lo(gb.z), 1e-30f), a1[1] * fmaxf(bf_hi(gb.z), 1e-30f));
                        w.w = cvt_pk_bf16(a1[2] * fmaxf(bf_lo(gb.w), 1e-30f), a1[3] * fmaxf(bf_hi(gb.w), 1e-30f));
                        *(u32x4*)(O + row * D + col0 + bj * 128) = w;
                    }
                    asm volatile("" ::: "memory");
                }
        }
    }
};
template <bool WITH_A2> struct EpiRes {
    static constexpr bool PERM = false, APERM = false;
    const float* xi; float* xo; bf16_t* a2; const float* mod; int gate_off; const float* g2; float* ss; bf16_t* x1b;
    __device__ __forceinline__ bool keep(const Unit&) const { return false; }
    __device__ __forceinline__ void operator()(f32x4 (&acc)[2][2][4][2], const Unit& u, int wr, int wc, int fr, int fq, LAS unsigned char*) const {
        const int b = (u.pm * 256) >> 12;
        const int row0 = u.pm * 256 + wr * 64 + fr, col0 = u.pn * 256 + wc * 32 + 4 * fq;
        f32x4 gt[2][2], sc[2][2];
#pragma unroll
        for (int bj = 0; bj < 2; ++bj)
#pragma unroll
            for (int n = 0; n < 2; ++n) {
                const int c = col0 + bj * 128 + n * 16;
                gt[bj][n] = *(const f32x4*)(mod + b * NADA + gate_off + c);
                if (WITH_A2) sc[bj][n] = *(const f32x4*)(g2 + c) * (*(const f32x4*)(mod + b * NADA + 4 * D + c) + 1.0f);
            }
#pragma unroll
        for (int ai = 0; ai < 2; ++ai)
#pragma unroll
            for (int m = 0; m < 4; ++m) {
                const int row = row0 + ai * 128 + m * 16; const size_t off = (size_t)row * D + col0;
                float q = 0.f;
#pragma unroll
                for (int bj = 0; bj < 2; ++bj) {
                    u32x2 wn[2], wx[2];
#pragma unroll
                    for (int n = 0; n < 2; ++n) {
                        const f32x4 xv = *(const f32x4*)(xi + off + bj * 128 + n * 16);
                        const f32x4 v = xv + gt[bj][n] * acc[ai][bj][m][n];
                        if (WITH_A2 && x1b) { wx[n].x = cvt_pk_bf16(v[0], v[1]); wx[n].y = cvt_pk_bf16(v[2], v[3]); }
                        else *(f32x4*)(xo + off + bj * 128 + n * 16) = v;
                        q += (v[0] * v[0] + v[1] * v[1]) + (v[2] * v[2] + v[3] * v[3]);
                        if (WITH_A2) { const f32x4 a = v * sc[bj][n]; wn[n].x = cvt_pk_bf16(a[0], a[1]); wn[n].y = cvt_pk_bf16(a[2], a[3]); }
                    }
                    if (WITH_A2 && x1b) {
                        const auto rx = __builtin_amdgcn_permlane16_swap(wx[0].x, wx[1].x, false, false), ry = __builtin_amdgcn_permlane16_swap(wx[0].y, wx[1].y, false, false);
                        *(u32x4*)(x1b + off + bj * 128 + ((fq & 1) ? 12 : 0)) = (u32x4){rx[0], ry[0], rx[1], ry[1]};
                    }
                    if (WITH_A2) {
                        const auto rx = __builtin_amdgcn_permlane16_swap(wn[0].x, wn[1].x, false, false), ry = __builtin_amdgcn_permlane16_swap(wn[0].y, wn[1].y, false, false);
                        const u32x4 w16 = (u32x4){rx[0], ry[0], rx[1], ry[1]};
                        const int cofs = (fq & 1) ? 16 + 4 * (fq - 1) - 4 * fq : 0;
                        *(u32x4*)(a2 + off + bj * 128 + cofs) = w16;
                    }
                }
                q += __shfl_xor(q, 16); q += __shfl_xor(q, 32);
                if (fq == 0) ss[(size_t)row * 16 + u.pn * 4 + wc] = q;
            }
    }
};
struct EpiTail {
    static constexpr bool PERM = false, APERM = false;
    float* xio; const float* mod; const float* gf; float* xbuf; unsigned* cnt; const bf16_t* x1b;
    __device__ __forceinline__ bool keep(const Unit&) const { return false; }
    __device__ __forceinline__ void operator()(f32x4 (&acc)[2][2][4][2], const Unit& u, int wr, int wc, int fr, int fq, LAS unsigned char* lds) const {
        const int b = (u.pm * 256) >> 12, tidx = tid_opaque();
        const int row0 = u.pm * 256 + wr * 64 + fr, col0 = u.pn * 256 + wc * 32 + 4 * fq;
        LAS float* P = (LAS float*)(lds + LDS_HALO);
        LAS float* S = (LAS float*)(lds + LDS_HALO + 4096);
        {
            f32x4 gt[2][2];
#pragma unroll
            for (int bj = 0; bj < 2; ++bj)
#pragma unroll
                for (int n = 0; n < 2; ++n) gt[bj][n] = *(const f32x4*)(mod + b * NADA + 5 * D + col0 + bj * 128 + n * 16);
#pragma unroll
            for (int ai = 0; ai < 2; ++ai)
#pragma unroll
                for (int m = 0; m < 4; ++m) {
                    const size_t off = (size_t)(row0 + ai * 128 + m * 16) * D + col0;
                    float q = 0.f;
#pragma unroll
                    for (int bj = 0; bj < 2; ++bj) {
                        const u32x4 L = *(const u32x4*)(x1b + off + bj * 128 + ((fq & 1) ? 12 : 0));
                        const auto rx = __builtin_amdgcn_permlane16_swap(L.x, L.z, false, false), ry = __builtin_amdgcn_permlane16_swap(L.y, L.w, false, false);
#pragma unroll
                        for (int n = 0; n < 2; ++n) {
                            const f32x4 xv = (f32x4){bf_lo(rx[n]), bf_hi(rx[n]), bf_lo(ry[n]), bf_hi(ry[n])};
                            const f32x4 v = xv + gt[bj][n] * acc[ai][bj][m][n];
                            acc[ai][bj][m][n] = v;
                            q += (v[0] * v[0] + v[1] * v[1]) + (v[2] * v[2] + v[3] * v[3]);
                        }
                    }
                    q += __shfl_xor(q, 16); q += __shfl_xor(q, 32);
                    if (fq == 0) P[(ai * 128 + wr * 64 + m * 16 + fr) * 4 + wc] = q;
                    asm volatile("" ::: "memory");
                }
        }
        asm volatile("s_waitcnt lgkmcnt(0)" ::: "memory"); __builtin_amdgcn_s_barrier(); asm volatile("" ::: "memory");
        if (tidx < 256) { const f32x4 p = *(const LAS f32x4*)(P + tidx * 4);
            __hip_atomic_store(xbuf + (size_t)(u.pm * 256 + tidx) * 4 + u.pn, (p[0] + p[1]) + (p[2] + p[3]), __ATOMIC_RELAXED, __HIP_MEMORY_SCOPE_AGENT); }
        asm volatile("s_waitcnt vmcnt(0)" ::: "memory"); __builtin_amdgcn_s_barrier(); asm volatile("" ::: "memory");
        if (tidx < 64) {
            if (tidx == 0) __hip_atomic_fetch_add(cnt + 64 * u.pm, 1u, __ATOMIC_RELAXED, __HIP_MEMORY_SCOPE_AGENT);
            unsigned sp = 0;
            while ((unsigned)__builtin_amdgcn_readfirstlane(__hip_atomic_load(cnt + 64 * u.pm, __ATOMIC_RELAXED, __HIP_MEMORY_SCOPE_AGENT)) < 4u) { __builtin_amdgcn_s_sleep(2); if (++sp > (1u << 22)) break; }
            __builtin_amdgcn_fence(__ATOMIC_ACQUIRE, "agent");
            asm volatile("s_waitcnt vmcnt(0)" ::: "memory");
        }
        __builtin_amdgcn_s_barrier(); asm volatile("" ::: "memory");
        if (tidx < 256) { const float* xp = xbuf + (size_t)(u.pm * 256 + tidx) * 4; float t = 0.f;
#pragma unroll
            for (int j = 0; j < 4; ++j) t += __hip_atomic_load(xp + j, __ATOMIC_RELAXED, __HIP_MEMORY_SCOPE_AGENT);
            S[tidx] = __builtin_amdgcn_rsqf(t * (1.0f / D) + EPS); }
        asm volatile("s_waitcnt vmcnt(0) lgkmcnt(0)" ::: "memory"); __builtin_amdgcn_s_barrier(); asm volatile("" ::: "memory");
        f32x4 gv[2][2];
#pragma unroll
        for (int bj = 0; bj < 2; ++bj)
#pragma unroll
            for (int n = 0; n < 2; ++n) gv[bj][n] = *(const f32x4*)(gf + col0 + bj * 128 + n * 16);
#pragma unroll
        for (int ai = 0; ai < 2; ++ai)
#pragma unroll
            for (int m = 0; m < 4; ++m) {
                const float rstd = S[ai * 128 + wr * 64 + m * 16 + fr];
                const size_t off = (size_t)(row0 + ai * 128 + m * 16) * D + col0;
#pragma unroll
                for (int bj = 0; bj < 2; ++bj)
#pragma unroll
                    for (int n = 0; n < 2; ++n) *(f32x4*)(xio + off + bj * 128 + n * 16) = acc[ai][bj][m][n] * rstd * gv[bj][n];
            }
    }
};
template <int CTRL> __device__ __forceinline__ float dpp_old(float old, float v) { return __int_as_float(__builtin_amdgcn_update_dpp(__float_as_int(old), __float_as_int(v), CTRL, 0xf, 0xf, false)); }
template <int CTRL> __device__ __forceinline__ float dpp_ror(float v) { return __int_as_float(__builtin_amdgcn_update_dpp(0, __float_as_int(v), CTRL, 0xf, 0xf, false)); }
struct Epi4 {
    static constexpr bool PERM = true, APERM = true;
    const float* ss2; const float* cb; const float* cw; bf16_t* F; int pre;
    __device__ __forceinline__ bool keep(const Unit&) const { return false; }
    __device__ __forceinline__ void operator()(f32x4 (&acc)[2][2][4][2], const Unit& u, int wr, int wc, int fr, int fq, LAS unsigned char* lds) const {
        const int grow0 = u.pm * MT4 - 2;
        LAS float* hal = (LAS float*)(lds + LDS_HALO);
        LAS float* rsT = (LAS float*)(lds + LDS_HALO + 8192) + (pre ? u.ord * 256 : 0);
        LAS int* infT = (LAS int*)(lds + LDS_HALO + 8192 + 6144);
        const int s0 = grow0 & (SEQ - 1);
        const bool fast = grow0 >= 0 && s0 >= 2 && s0 + 255 < SEQ && grow0 + 255 < M;
        if (pre == 0 || !fast) {
            const int tidx = tid_opaque();
            if (tidx < 256) {
                const int lr = tidx, gr = grow0 + lr, grc = gr < 0 ? 0 : (gr > M - 1 ? M - 1 : gr);
                if (pre == 0) { const f32x4* p = (const f32x4*)(ss2 + (size_t)grc * 16);
                    const f32x4 st = (p[0] + p[1]) + (p[2] + p[3]);
                    rsT[lr] = __builtin_amdgcn_rsqf(((st[0] + st[1]) + (st[2] + st[3])) * (1.0f / D) + EPS); }
                const int sq = grc & (SEQ - 1), b = grc >> 12, sidx = sq < 2 ? sq : 2;
                infT[lr] = (sidx * 4 + b) | (sq >= 1 ? 16 : 0) | (sq >= 2 ? 32 : 0) | ((lr >= 2 && gr < M) ? 64 : 0);
            }
            asm volatile("s_waitcnt lgkmcnt(0)" ::: "memory"); __builtin_amdgcn_s_barrier(); asm volatile("" ::: "memory");
        }
#pragma unroll
        for (int ai = 0; ai < 2; ++ai)
#pragma unroll
            for (int m = 0; m < 4; ++m) {
                const float rstd = rsT[ai * 128 + wr * 64 + 4 * fr + m];
#pragma unroll
                for (int bj = 0; bj < 2; ++bj)
#pragma unroll
                    for (int n = 0; n < 2; ++n) acc[ai][bj][m][n] *= rstd;
            }
        const int ccol = wc * 32 + 8 * fq;
        if (fr == 15) {
#pragma unroll
            for (int ai = 0; ai < 2; ++ai)
#pragma unroll
                for (int bj = 0; bj < 2; ++bj)
#pragma unroll
                    for (int n = 0; n < 2; ++n) {
                        *(LAS f32x4*)(hal + ((ai * 2 + wr) * 2 + 0) * 256 + bj * 128 + ccol + 4 * n) = acc[ai][bj][2][n];
                        *(LAS f32x4*)(hal + ((ai * 2 + wr) * 2 + 1) * 256 + bj * 128 + ccol + 4 * n) = acc[ai][bj][3][n];
                    }
        }
        asm volatile("s_waitcnt lgkmcnt(0)" ::: "memory"); __builtin_amdgcn_s_barrier(); asm volatile("" ::: "memory");
        if (fast) conv<true>(acc, u, wr, wc, fr, fq, hal, infT, grow0);
        else conv<false>(acc, u, wr, wc, fr, fq, hal, infT, grow0);
    }
    template <bool FAST> __device__ __forceinline__ void conv(f32x4 (&acc)[2][2][4][2], const Unit& u, int wr, int wc, int fr, int fq, LAS float* hal, LAS int* infT, int grow0) const {
        const int ccol = wc * 32 + 8 * fq;
        const int ncol0 = u.pn * 256 + ccol;
        const int cidx = 8 + (grow0 >> 12);
        u32x2 pk0[2][4];
#pragma unroll
        for (int n = 0; n < 2; ++n) {
            f32x4 w0[2], w1[2], w2[2], cbc[2];
#pragma unroll
            for (int bj = 0; bj < 2; ++bj) { const int c = ncol0 + bj * 128 + 4 * n; w0[bj] = *(const f32x4*)(cw + c); w1[bj] = *(const f32x4*)(cw + NUP + c); w2[bj] = *(const f32x4*)(cw + 2 * NUP + c);
                if (FAST) cbc[bj] = *(const f32x4*)(cb + (size_t)cidx * NUP + c); }
#pragma unroll
            for (int ai = 0; ai < 2; ++ai) {
                const int grp = ai * 2 + wr;
                f32x4 P3[2], P2[2];
#pragma unroll
                for (int bj = 0; bj < 2; ++bj) {
                    f32x4 c1, c2;
                    if (grp > 0) { c1 = *(const LAS f32x4*)(hal + ((grp - 1) * 2 + 1) * 256 + bj * 128 + ccol + 4 * n); c2 = *(const LAS f32x4*)(hal + ((grp - 1) * 2 + 0) * 256 + bj * 128 + ccol + 4 * n); }
                    else { c1 = (f32x4){0.f, 0.f, 0.f, 0.f}; c2 = (f32x4){0.f, 0.f, 0.f, 0.f}; }
#pragma unroll
                    for (int j = 0; j < 4; ++j) { P3[bj][j] = dpp_old<0x111>(c1[j], acc[ai][bj][3][n][j]); P2[bj][j] = dpp_old<0x111>(c2[j], acc[ai][bj][2][n][j]); }
                }
#pragma unroll
                for (int m = 0; m < 4; ++m) {
                    const int lr = ai * 128 + wr * 64 + 4 * fr + m;
                    int info = 0; if (!FAST) info = infT[lr];
                    f32x4 val[2];
#pragma unroll
                    for (int bj = 0; bj < 2; ++bj) {
                        const f32x4 Xm = acc[ai][bj][m][n];
                        f32x4 S1 = m == 0 ? P3[bj] : acc[ai][bj][m > 0 ? m - 1 : 0][n];
                        f32x4 S2 = m == 0 ? P2[bj] : (m == 1 ? P3[bj] : acc[ai][bj][m > 1 ? m - 2 : 0][n]);
                        f32x4 cbv;
                        if (FAST) cbv = cbc[bj];
                        else { cbv = *(const f32x4*)(cb + (size_t)(info & 15) * NUP + ncol0 + bj * 128 + 4 * n);
#pragma unroll
                            for (int j = 0; j < 4; ++j) { S1[j] = (info & 16) ? S1[j] : 0.f; S2[j] = (info & 32) ? S2[j] : 0.f; } }
                        val[bj] = cbv + w2[bj] * Xm + w1[bj] * S1 + w0[bj] * S2;
                    }
                    f32x4 f;
#pragma unroll
                    for (int j = 0; j < 4; ++j) f[j] = val[0][j] * sigmoid_f(val[0][j]) * val[1][j];
                    u32x2 w; w.x = cvt_pk_bf16(f[0], f[1]); w.y = cvt_pk_bf16(f[2], f[3]);
                    bool st = lr >= 2; if (!FAST) st = (info & 64) != 0;
                    if (n == 0) pk0[ai][m] = w;
                    else if (st) *(u32x4*)(F + (size_t)(grow0 + lr) * DFF + u.pn * 128 + ccol) = (u32x4){pk0[ai][m].x, pk0[ai][m].y, w.x, w.y};
                }
                if (!FAST) asm volatile("" ::: "memory");
            }
        }
    }
};


#define XB_TMO      128
#define XB_XCNT(j)  (256  + 64 * (j))
#define XB_XSUB(j)  (1280 + 64 * (j))
#define XB_XGEN(j)  (2304 + 64 * (j))
#define XB_TOP      3328
#define XB_TOPGEN   3392
#define XCD_BAR_WORDS 3456
#define XB_SPIN_CAP (1u << 22)
__device__ __forceinline__ unsigned xb_ld(unsigned* p)              { return __hip_atomic_load(p, __ATOMIC_RELAXED, __HIP_MEMORY_SCOPE_AGENT); }
__device__ __forceinline__ unsigned xb_add(unsigned* p, unsigned v) { return __hip_atomic_fetch_add(p, v, __ATOMIC_RELAXED, __HIP_MEMORY_SCOPE_AGENT); }
__device__ __forceinline__ unsigned xb_xcc_id() { return (unsigned)__builtin_amdgcn_s_getreg((3 << 11) | 20) & 0xFu; }
#define XB_SPIN(cond, bar) do { unsigned _sp = 0; while (cond) { __builtin_amdgcn_s_sleep(1); \
    if ((++_sp & 255u) == 0u) { if (xb_ld(&(bar)[XB_TMO])) break; if (_sp > XB_SPIN_CAP) { atomicAdd(&(bar)[XB_TMO], 1u); break; } } } } while (0)
struct XcdBarrier { unsigned* bar; unsigned x; volatile LAS unsigned* st; };
__device__ __forceinline__ XcdBarrier xcd_barrier_post(unsigned* bar, volatile LAS unsigned* st) {
    XcdBarrier b; b.bar = bar; b.x = xb_xcc_id(); b.st = st;
    if (threadIdx.x == 0) (void)xb_add(&bar[XB_XCNT(b.x)], 1u);
    return b;
}
__device__ __forceinline__ void xcd_barrier_complete(unsigned* bar, unsigned x, unsigned& nloc, unsigned& nx) {
    const unsigned G = gridDim.x * gridDim.y * gridDim.z;
    unsigned sum, cnt, mine, sp = 0u;
    for (;;) {
        sum = 0u; cnt = 0u; mine = 0u;
#pragma unroll
        for (unsigned j = 0; j < 16; ++j) { const unsigned c = xb_ld(&bar[XB_XCNT(j)]); sum += c; cnt += (c > 0u) ? 1u : 0u; mine = (j == x) ? c : mine; }
        if (sum == G) break;
        __builtin_amdgcn_s_sleep(1);
        if ((++sp & 255u) == 0u) { if (xb_ld(&bar[XB_TMO])) break; if (sp > XB_SPIN_CAP) { atomicAdd(&bar[XB_TMO], 1u); break; } }
    }
    nloc = mine > 0u ? mine : 1u; nx = cnt > 0u ? cnt : 1u;
}
__device__ __forceinline__ void xcd_barrier(const XcdBarrier& b) {
    asm volatile("s_waitcnt vmcnt(0)" ::: "memory");
    __syncthreads();
    if (threadIdx.x == 0) {
        unsigned* bar = b.bar;
        __builtin_amdgcn_s_waitcnt(0);
        unsigned nloc = b.st[0], nx = b.st[1];
        if (nloc == 0u) { xcd_barrier_complete(bar, b.x, nloc, nx); b.st[0] = nloc; b.st[1] = nx; }
        const unsigned old = xb_add(&bar[XB_XSUB(b.x)], 1u);
        const unsigned gen = old / nloc;
        if (old + 1u == (gen + 1u) * nloc) {
            __builtin_amdgcn_fence(__ATOMIC_RELEASE, "agent");
            asm volatile("s_waitcnt vmcnt(0)" ::: "memory");
            const unsigned og = xb_add(&bar[XB_TOP], 1u);
            const unsigned tg = og / nx;
            if (og + 1u == (tg + 1u) * nx) xb_add(&bar[XB_TOPGEN], 1u);
            else XB_SPIN(xb_ld(&bar[XB_TOPGEN]) == tg, bar);
            __builtin_amdgcn_fence(__ATOMIC_ACQUIRE, "agent");
            xb_add(&bar[XB_XGEN(b.x)], 1u);
            asm volatile("s_waitcnt vmcnt(0)" ::: "memory");
        } else {
            XB_SPIN(xb_ld(&bar[XB_XGEN(b.x)]) == gen, bar);
            __builtin_amdgcn_fence(__ATOMIC_ACQUIRE, "agent");
            asm volatile("s_waitcnt vmcnt(0)" ::: "memory");
        }
    }
    __syncthreads();
}

struct Args { const float* in[24]; float* out; unsigned char* ws; int use_cg; int pad; };

__device__ __forceinline__ void transpose_item(const float* W, int K, int N, bf16_t* WT, int dst_row0, int k0, int n0, float* scr, int lane) {
    {   f32x4 v[8];
#pragma unroll
        for (int i = 0; i < 8; ++i) v[i] = __builtin_nontemporal_load((const f32x4*)(W + (size_t)(k0 + 8 * i + (lane >> 3)) * N + n0 + (lane & 7) * 4));
#pragma unroll
        for (int i = 0; i < 8; ++i) { float* d = scr + (8 * i + (lane >> 3)) * 33 + (lane & 7) * 4; d[0] = v[i][0]; d[1] = v[i][1]; d[2] = v[i][2]; d[3] = v[i][3]; }
    }
    asm volatile("s_waitcnt lgkmcnt(0)" ::: "memory");
    const int c = lane & 7;
#pragma unroll
    for (int j = 0; j < 4; ++j) { const int n = (lane >> 3) + 8 * j; const float* s = scr + (8 * c) * 33 + n;
        u32x4 o; o.x = cvt_pk_bf16(s[0 * 33], s[1 * 33]); o.y = cvt_pk_bf16(s[2 * 33], s[3 * 33]); o.z = cvt_pk_bf16(s[4 * 33], s[5 * 33]); o.w = cvt_pk_bf16(s[6 * 33], s[7 * 33]);
        *(u32x4*)(WT + (size_t)(dst_row0 + n) * K + k0 + 8 * c) = o; }
    asm volatile("s_waitcnt lgkmcnt(0)" ::: "memory");
}
__device__ __forceinline__ void phase0(const Args& a, unsigned char* smem) {
    const int tid = tid_opaque(), lane = tid & 63, wave = tid >> 6, G = gridDim.x;
    unsigned char* ws = a.ws;
    float* sc = (float*)(smem + 72 * 1024);
    float* red = (float*)(smem + 88 * 1024);
    const float* c = a.in[1];
    for (int i = tid; i < 4 * D; i += 512) { const float v = c[i]; sc[i] = v * sigmoid_f(v); }
    __syncthreads();
    const float* w_ada = a.in[2]; const float* b_ada = a.in[3]; float* mod = (float*)(ws + WS_MOD);
    unsigned* modctr = (unsigned*)(ws + WS_CTL + 49152);
    for (int nc = blockIdx.x; nc < NADA / 24; nc += G) {
        const int n0 = nc * 24, col = lane & 31, par = lane >> 5; const bool act = col < 24;
        float a0 = 0.f, a1 = 0.f, a2 = 0.f, a3 = 0.f;
#pragma unroll 8
        for (int i = 0; i < 64; ++i) { const int k = wave * 128 + 2 * i + par; const float w = act ? __builtin_nontemporal_load(w_ada + (size_t)k * NADA + n0 + col) : 0.f;
            a0 += sc[k] * w; a1 += sc[D + k] * w; a2 += sc[2 * D + k] * w; a3 += sc[3 * D + k] * w; }
        a0 += __shfl_xor(a0, 32); a1 += __shfl_xor(a1, 32); a2 += __shfl_xor(a2, 32); a3 += __shfl_xor(a3, 32);
        if (lane < 32) { red[(wave * 4 + 0) * 32 + col] = a0; red[(wave * 4 + 1) * 32 + col] = a1; red[(wave * 4 + 2) * 32 + col] = a2; red[(wave * 4 + 3) * 32 + col] = a3; }
        __syncthreads();
        if (tid < 128) { const int b = tid >> 5, cc = tid & 31;
            if (cc < 24) { float s = b_ada[n0 + cc];
#pragma unroll
                for (int w = 0; w < 8; ++w) s += red[(w * 4 + b) * 32 + cc];
                __hip_atomic_store(mod + b * NADA + n0 + cc, s, __ATOMIC_RELAXED, __HIP_MEMORY_SCOPE_AGENT); } }
        asm volatile("s_waitcnt vmcnt(0)" ::: "memory");
        __syncthreads();
        if (tid == 0) __hip_atomic_fetch_add(modctr, 1u, __ATOMIC_RELAXED, __HIP_MEMORY_SCOPE_AGENT);
    }
    float* scr = (float*)(smem + wave * 17408);
    const int gw = blockIdx.x * 8 + wave, NGW = G * 8;
    constexpr int I_IN = 16 * 64, I_GATE = 16 * 64, I_SQ = 16 * 32, I_UP = 16 * 176, I_DN = 44 * 32, I_PC = 4 * 8 * 64;
    constexpr int NITEMS = I_IN + I_GATE + 3 * I_SQ + I_UP + I_DN + I_PC;
    const int nj = (NITEMS - gw + NGW - 1) / NGW; const bool revo = ((wave >> 2) & 1) == 0;
    for (int jj = 0; jj < nj; ++jj) {
        const int it = gw + NGW * (revo ? nj - 1 - jj : jj);
        int r = it;
        if (r < I_IN) { const int nb = 64, kb = r / nb, n0 = (r % nb) * 32; transpose_item(a.in[5], D, 3 * D, (bf16_t*)(ws + WS_W1T), n0, kb * 64, n0, scr, lane); continue; } r -= I_IN;
        if (r < I_GATE) { const int nb = 64, kb = r / nb, n0 = (r % nb) * 32; transpose_item(a.in[15], D, 2 * D, (bf16_t*)(ws + WS_W1T), 3 * D + n0, kb * 64, n0, scr, lane); continue; } r -= I_GATE;
        if (r < I_SQ) { const int kb = r / 32, n0 = (r % 32) * 32; transpose_item(a.in[13], D, D, (bf16_t*)(ws + WS_WPA), n0, kb * 64, n0, scr, lane); continue; } r -= I_SQ;
        if (r < I_SQ) { const int kb = r / 32, n0 = (r % 32) * 32; transpose_item(a.in[14], D, D, (bf16_t*)(ws + WS_WPB), n0, kb * 64, n0, scr, lane); continue; } r -= I_SQ;
        if (r < I_SQ) { const int kb = r / 32, n0 = (r % 32) * 32; transpose_item(a.in[17], D, D, (bf16_t*)(ws + WS_WOUT), n0, kb * 64, n0, scr, lane); continue; } r -= I_SQ;
        if (r < I_UP) { const int nb = 176, kb = r / nb, n0 = (r % nb) * 32; const int half = n0 >= DFF ? 1 : 0, j = n0 - half * DFF;
            transpose_item(a.in[19], D, NUP, (bf16_t*)(ws + WS_WUP), (j >> 7) * 256 + half * 128 + (j & 127), kb * 64, n0, scr, lane); continue; } r -= I_UP;
        if (r < I_DN) { const int kb = r / 32, n0 = (r % 32) * 32; transpose_item(a.in[22], DFF, D, (bf16_t*)(ws + WS_WDN), n0, kb * 64, n0, scr, lane); continue; } r -= I_DN;
        {
            const int g = r >> 9, q = r & 511, n0 = (q >> 6) * 32, k0 = (q & 63) * 16, nn = lane & 31, kh = lane >> 5;
            float* At = (float*)(smem + wave * 17408);
            { const float* Ag = a.in[5] + (size_t)k0 * (3 * D) + 2 * D + g * 256; f32x4 av[16];
#pragma unroll
              for (int i = 0; i < 16; ++i) av[i] = *(const f32x4*)(Ag + (size_t)i * (3 * D) + 4 * lane);
#pragma unroll
              for (int i = 0; i < 16; ++i) *(f32x4*)(At + i * 260 + 4 * lane) = av[i]; }
            asm volatile("s_waitcnt lgkmcnt(0)" ::: "memory");
            const float* Bp = a.in[10] + (size_t)g * 65536 + n0 + nn;
            const float* Ar = At + (kh * 8) * 260;
            float accp[8];
#pragma unroll
            for (int i = 0; i < 8; ++i) accp[i] = 0.f;
#pragma unroll 2
            for (int c0 = 0; c0 < 256; c0 += 32) {
                float bv[32];
#pragma unroll
                for (int j = 0; j < 32; ++j) bv[j] = Bp[(size_t)(c0 + j) * 256];
#pragma unroll
                for (int i = 0; i < 8; ++i)
#pragma unroll
                    for (int j = 0; j < 32; j += 4) { const f32x4 a4 = *(const f32x4*)(Ar + i * 260 + c0 + j); accp[i] += (a4[0] * bv[j] + a4[1] * bv[j + 1]) + (a4[2] * bv[j + 2] + a4[3] * bv[j + 3]); }
            }
            u32x4 o; o.x = cvt_pk_bf16(accp[0], accp[1]); o.y = cvt_pk_bf16(accp[2], accp[3]); o.z = cvt_pk_bf16(accp[4], accp[5]); o.w = cvt_pk_bf16(accp[6], accp[7]);
            *(u32x4*)((bf16_t*)(ws + WS_W1T) + (size_t)(2 * D + g * 256 + n0 + nn) * D + k0 + kh * 8) = o;
            asm volatile("s_waitcnt lgkmcnt(0)" ::: "memory");
        }
    }
    { const float* wsp = a.in[8]; bf16_t* o = (bf16_t*)(ws + WS_WSP);
      for (int i = blockIdx.x * 512 + tid; i < 8 * 128 * 128 / 2; i += G * 512) { const int e = 2 * i, p = (e >> 7) & 127, q = e & 127; const bool ok = (q >> 6) <= (p >> 6);
          const f32x2 v = *(const f32x2*)(wsp + e); ((unsigned*)o)[i] = ok ? cvt_pk_bf16(v.x, v.y) : 0u; } }
    if (tid < 64) { unsigned sp = 0;
        while ((unsigned)__builtin_amdgcn_readfirstlane(__hip_atomic_load(modctr, __ATOMIC_RELAXED, __HIP_MEMORY_SCOPE_AGENT)) < (unsigned)(NADA / 24)) { __builtin_amdgcn_s_sleep(2); if (++sp > (1u << 22)) break; }
        __builtin_amdgcn_fence(__ATOMIC_ACQUIRE, "agent");
        asm volatile("s_waitcnt vmcnt(0)" ::: "memory"); }
    __syncthreads();
    const float* x = a.in[0]; const float* g1 = a.in[4]; bf16_t* H = (bf16_t*)(ws + WS_H);
    for (int rg = gw; rg < M / 8; rg += NGW) {
        const int r0 = rg * 8, b = r0 >> 12;
        f32x4 scl[4], sft[4];
#pragma unroll
        for (int j = 0; j < 4; ++j) { const int c = 4 * lane + 256 * j; scl[j] = *(const f32x4*)(g1 + c) * (*(const f32x4*)(mod + b * NADA + D + c) + 1.0f); sft[j] = *(const f32x4*)(mod + b * NADA + c); }
#pragma unroll 2
        for (int r = 0; r < 8; ++r) {
            const float* xr = x + (size_t)(r0 + r) * D + 4 * lane; f32x4 v[4]; float ss = 0.f;
#pragma unroll
            for (int j = 0; j < 4; ++j) { v[j] = __builtin_nontemporal_load((const f32x4*)(xr + 256 * j)); ss += (v[j][0] * v[j][0] + v[j][1] * v[j][1]) + (v[j][2] * v[j][2] + v[j][3] * v[j][3]); }
            const float rstd = __builtin_amdgcn_rsqf(wave_sum(ss) * (1.0f / D) + EPS);
            bf16_t* hr = H + (size_t)(r0 + r) * D + 4 * lane;
#pragma unroll
            for (int j = 0; j < 4; ++j) { const f32x4 o = v[j] * rstd * scl[j] + sft[j]; u32x2 w; w.x = cvt_pk_bf16(o[0], o[1]); w.y = cvt_pk_bf16(o[2], o[3]); *(u32x2*)(hr + 256 * j) = w; }
        }
    }
}

__device__ __forceinline__ void phase1(const Args& a, unsigned char* smem) {
    const int tid = tid_opaque(), lane = tid & 63, wave = tid >> 6, G = gridDim.x;
    unsigned char* ws = a.ws; const float* mod = (const float*)(ws + WS_MOD);
    const float* x = a.in[0]; const float* g1 = a.in[4]; bf16_t* H = (bf16_t*)(ws + WS_H);
    const int gw = blockIdx.x * 8 + wave, NGW = G * 8;
    float* sh2 = (float*)smem;
    for (int i = tid; i < 4 * D; i += 512) sh2[i] = mod[(i >> 10) * NADA + 3 * D + (i & 1023)];
    __syncthreads();
    const bf16_t* Wup = (const bf16_t*)(ws + WS_WUP); const float* convw = a.in[20]; const float* convb = a.in[21];
    float* cb = (float*)(ws + WS_CB); float* cw = (float*)(ws + WS_CW);
    for (int np = gw; np < NUP; np += NGW) {
        float d0 = 0.f, d1 = 0.f, d2 = 0.f, d3 = 0.f;
#pragma unroll
        for (int j = 0; j < 2; ++j) { const int k0 = 8 * lane + 512 * j; const u32x4 w = *(const u32x4*)(Wup + (size_t)np * D + k0);
#pragma unroll
            for (int e = 0; e < 4; ++e) { const float lo = bf_lo(w[e]), hi = bf_hi(w[e]); const int k = k0 + 2 * e;
                d0 += lo * sh2[k] + hi * sh2[k + 1]; d1 += lo * sh2[D + k] + hi * sh2[D + k + 1]; d2 += lo * sh2[2 * D + k] + hi * sh2[2 * D + k + 1]; d3 += lo * sh2[3 * D + k] + hi * sh2[3 * D + k + 1]; } }
        d0 = wave_sum(d0); d1 = wave_sum(d1); d2 = wave_sum(d2); d3 = wave_sum(d3);
        const int pn = np >> 8, r = np & 255, half = r >> 7, jl = r & 127, n = half * DFF + pn * 128 + jl;
        const float w0 = convw[n], w1 = convw[NUP + n], w2 = convw[2 * NUP + n], cbv = convb[n];
        if (lane < 12) { const int sidx = lane >> 2, b = lane & 3; const float sw = sidx == 0 ? w2 : (sidx == 1 ? w1 + w2 : w0 + w1 + w2); const float dv = b == 0 ? d0 : (b == 1 ? d1 : (b == 2 ? d2 : d3));
            cb[(size_t)(sidx * 4 + b) * NUP + np] = cbv + dv * sw; }
        else if (lane < 15) { const int k = lane - 12; cw[k * NUP + np] = k == 0 ? w0 : (k == 1 ? w1 : w2); }
    }
}

__device__ __forceinline__ void phase3(const Args& a, unsigned char* smem) {
    const int G = gridDim.x;
    unsigned char* ws = a.ws;
    bf16_t* U = (bf16_t*)(ws + WS_U); const bf16_t* V = (const bf16_t*)(ws + WS_V); const bf16_t* ZB = (const bf16_t*)(ws + WS_ZB); bf16_t* YB = (bf16_t*)(ws + WS_H);
    const float* vst = (const float*)(ws + WS_VST);
    const bf16_t* Wsp = (const bf16_t*)(ws + WS_WSP);
    const float* lng = a.in[6]; const float* lnb = a.in[7]; const float* bsp = a.in[9]; const float* bpool = a.in[11]; const float* pscale = a.in[12];
#ifndef REP_POOL
#define REP_POOL 1
#endif
#ifndef REP_SPAT
#define REP_SPAT 1
#endif
    for (int it0 = blockIdx.x; it0 < REP_POOL * 512 + REP_SPAT * 1024; it0 += G) {
        int it = it0 < REP_POOL * 512 ? (it0 & 511) : it0 - (REP_POOL - 1) * 512; bool do_store = true;
        if (it >= 512 + 1024) { it -= 1024; do_store = (a.use_cg == 77); }
        __syncthreads();
        const int tid = tid_opaque(), lane = tid & 63, wave = tid >> 6, wr = wave >> 2, wc = wave & 3, fr = lane & 15, fq = lane >> 4;
        if (it < 512) {
            const int tb = it >> 2, g = it & 3, m0 = tb * 128, c0 = g * 256, w = 2 << g, sqm0 = m0 & (SEQ - 1);
            bf16_t* Raw = (bf16_t*)smem;
            {   u32x4 zr[9];
#pragma unroll
                for (int j = 0; j < 9; ++j) { const int idx = tid + 512 * j, r = idx >> 5, cc = idx & 31;
                    zr[j] = (u32x4){0u, 0u, 0u, 0u};
                    if (r >= 16 || sqm0 != 0) zr[j] = *(const u32x4*)(ZB + (size_t)(m0 - 16 + r) * D + c0 + cc * 8); }
#pragma unroll
                for (int j = 0; j < 9; ++j) { const int idx = tid + 512 * j, r = idx >> 5, cc = idx & 31; *(u32x4*)(Raw + r * 264 + cc * 8) = zr[j]; }
            }
            const int cc = tid & 31, strip = tid >> 5, lr0 = strip * 8;
            const f32x4 bp0 = *(const f32x4*)(bpool + c0 + cc * 8), bp1 = *(const f32x4*)(bpool + c0 + cc * 8 + 4), ps0 = *(const f32x4*)(pscale + c0 + cc * 8), ps1 = *(const f32x4*)(pscale + c0 + cc * 8 + 4);
            __syncthreads();
            { const bf16_t* rp = Raw + (lr0 + 16) * 264 + cc * 8;
              float sum[8];
#pragma unroll
              for (int e = 0; e < 8; ++e) sum[e] = 0.f;
              for (int j = 1; j < w; ++j) { const u32x4 z = *(const u32x4*)(rp - j * 264);
#pragma unroll
                  for (int e = 0; e < 4; ++e) { sum[2 * e] += bf_lo(z[e]); sum[2 * e + 1] += bf_hi(z[e]); } }
#pragma unroll
              for (int i = 0; i < 8; ++i) {
                  const u32x4 z = *(const u32x4*)(rp + i * 264); const int sq = sqm0 + lr0 + i; const float inv = 1.0f / (float)(sq + 1 < w ? sq + 1 : w);
                  float o[8];
#pragma unroll
                  for (int e = 0; e < 4; ++e) { const float lo = bf_lo(z[e]), hi = bf_hi(z[e]); sum[2 * e] += lo; sum[2 * e + 1] += hi; o[2 * e] = sum[2 * e] * inv - lo; o[2 * e + 1] = sum[2 * e + 1] * inv - hi; }
#pragma unroll
                  for (int e = 0; e < 8; ++e) o[e] = (o[e] + (e < 4 ? bp0[e & 3] : bp1[e & 3])) * (e < 4 ? ps0[e & 3] : ps1[e & 3]);
                  u32x4 pw; pw.x = cvt_pk_bf16(o[0], o[1]); pw.y = cvt_pk_bf16(o[2], o[3]); pw.z = cvt_pk_bf16(o[4], o[5]); pw.w = cvt_pk_bf16(o[6], o[7]);
                  *(u32x4*)(YB + (size_t)(m0 + lr0 + i) * D + c0 + cc * 8) = pw;
                  const u32x4 zo = *(const u32x4*)(rp + (i - (w - 1)) * 264);
#pragma unroll
                  for (int e = 0; e < 4; ++e) { sum[2 * e] -= bf_lo(zo[e]); sum[2 * e + 1] -= bf_hi(zo[e]); }
              } }
        } else {
            const int si = it - 512, nb = si >> 3, g = si & 7, m0 = nb * 128, c0 = g * 128;
            bf16_t* vT = (bf16_t*)smem;
            float* st = (float*)(smem + 36864);
            const int kmax = wr == 0 ? 2 : 4;
            const bf16_t* Ap = Wsp + (size_t)g * 16384 + (size_t)(64 * wr + fr) * 128 + 8 * fq;
            bf16x8 Af[4][4];
#pragma unroll
            for (int ks = 0; ks < 4; ++ks)
#pragma unroll
                for (int m = 0; m < 4; ++m) Af[ks][m] = (ks < kmax) ? *(const bf16x8*)(Ap + m * 16 * 128 + ks * 32) : (bf16x8){0, 0, 0, 0, 0, 0, 0, 0};
            const int d0 = (tid & 15) * 8;
            u32x4 zv[4];
#pragma unroll
            for (int j = 0; j < 4; ++j) zv[j] = *(const u32x4*)(V + (size_t)(m0 + ((tid + 512 * j) >> 4)) * D + c0 + d0);
            u32x4 uu[4];
#pragma unroll
            for (int m = 0; m < 4; ++m) uu[m] = *(const u32x4*)(U + (size_t)(m0 + 64 * wr + 16 * m + fr) * D + c0 + 32 * wc + 8 * fq);
            const f32x4 ga = *(const f32x4*)(lng + c0 + d0), gb2 = *(const f32x4*)(lng + c0 + d0 + 4), ba = *(const f32x4*)(lnb + c0 + d0), bb = *(const f32x4*)(lnb + c0 + d0 + 4);
            if (tid < 128) { const f32x4* p = (const f32x4*)(vst + (size_t)(m0 + tid) * 32); float sm = 0.f, q = 0.f;
#pragma unroll
                for (int j = 0; j < 8; ++j) { const f32x4 t = p[j]; sm += t[0] + t[2]; q += t[1] + t[3]; }
                const float mu = sm * (1.0f / D), var = q * (1.0f / D) - mu * mu; st[2 * tid] = mu; st[2 * tid + 1] = __builtin_amdgcn_rsqf(var + EPS); }
            __syncthreads();
#pragma unroll
            for (int j = 0; j < 4; ++j) { const int q = (tid + 512 * j) >> 4;
                const u32x4 z = zv[j]; const float mu = st[2 * q], rs = st[2 * q + 1];
                float o[8];
#pragma unroll
                for (int e = 0; e < 4; ++e) { o[2 * e] = bf_lo(z[e]); o[2 * e + 1] = bf_hi(z[e]); }
#pragma unroll
                for (int e = 0; e < 8; ++e) { const float gg = e < 4 ? ga[e & 3] : gb2[e & 3], bbv = e < 4 ? ba[e & 3] : bb[e & 3]; const float y = (o[e] - mu) * rs * gg + bbv;
                    const int d = d0 + e, sw = ((d >> 3) ^ d) & 15;
                    vT[d * 128 + ((((q >> 3) ^ sw) << 3) | (q & 7))] = (bf16_t)(cvt_pk_bf16(y, 0.f) & 0xffffu); } }
            __syncthreads();
            f32x4 acc[4][2];
#pragma unroll
            for (int m = 0; m < 4; ++m)
#pragma unroll
                for (int n = 0; n < 2; ++n) acc[m][n] = (f32x4){0.f, 0.f, 0.f, 0.f};
#pragma unroll
            for (int ks = 0; ks < 4; ++ks) {
                if (ks < kmax) {
                    bf16x8 Bf[2];
#pragma unroll
                    for (int n = 0; n < 2; ++n) { const int d = 32 * wc + 8 * (fr >> 2) + 4 * n + (fr & 3), sw = ((d >> 3) ^ d) & 15; Bf[n] = *(const bf16x8*)(vT + d * 128 + (((ks * 4 + fq) ^ sw) << 3)); }
#pragma unroll
                    for (int m = 0; m < 4; ++m)
#pragma unroll
                        for (int n = 0; n < 2; ++n) acc[m][n] = __builtin_amdgcn_mfma_f32_16x16x32_bf16(Bf[n], Af[ks][m], acc[m][n], 0, 0, 0);
                }
            }
#pragma unroll
            for (int m = 0; m < 4; ++m) { const int p = 64 * wr + 16 * m + fr; const float bs = bsp[g * 128 + p];
                { bf16_t* up = U + (size_t)(m0 + p) * D + c0 + 32 * wc + 8 * fq; const u32x4 uv = uu[m];
                    u32x4 o;
                    o.x = cvt_pk_bf16(bf_lo(uv.x) * (acc[m][0][0] + bs), bf_hi(uv.x) * (acc[m][0][1] + bs)); o.y = cvt_pk_bf16(bf_lo(uv.y) * (acc[m][0][2] + bs), bf_hi(uv.y) * (acc[m][0][3] + bs));
                    o.z = cvt_pk_bf16(bf_lo(uv.z) * (acc[m][1][0] + bs), bf_hi(uv.z) * (acc[m][1][1] + bs)); o.w = cvt_pk_bf16(bf_lo(uv.w) * (acc[m][1][2] + bs), bf_hi(uv.w) * (acc[m][1][3] + bs));
                    if (do_store) *(u32x4*)up = o; } }
        }
    }
}

__device__ __forceinline__ void phase9(const Args& a) {
    const int tid = tid_opaque(), lane = tid & 63, wave = tid >> 6, G = gridDim.x;
    const float* ss3 = (const float*)(a.ws + WS_SS3); const float* gf = a.in[23]; float* out = a.out;
    const int gw = blockIdx.x * 8 + wave, NGW = G * 8;
    f32x4 gv[4];
#pragma unroll
    for (int j = 0; j < 4; ++j) gv[j] = *(const f32x4*)(gf + 4 * lane + 256 * j);
    for (int row0 = gw * 4; row0 < M; row0 += NGW * 4) {
        f32x4 v[4][4]; float rstd[4];
#pragma unroll
        for (int r = 0; r < 4; ++r) {
            const f32x4* p = (const f32x4*)(ss3 + (size_t)(row0 + r) * 16); const f32x4 st = (p[0] + p[1]) + (p[2] + p[3]);
            rstd[r] = __builtin_amdgcn_rsqf(((st[0] + st[1]) + (st[2] + st[3])) * (1.0f / D) + EPS);
            const float* xr = out + (size_t)(row0 + r) * D + 4 * lane;
#pragma unroll
            for (int j = 0; j < 4; ++j) v[r][j] = *(const f32x4*)(xr + 256 * j);
        }
#pragma unroll
        for (int r = 0; r < 4; ++r) { float* xr = out + (size_t)(row0 + r) * D + 4 * lane;
#pragma unroll
            for (int j = 0; j < 4; ++j) *(f32x4*)(xr + 256 * j) = v[r][j] * rstd[r] * gv[j]; }
    }
}

__global__ void __launch_bounds__(512, 2) fwd_megakernel(Args a) {
    extern __shared__ __attribute__((aligned(16))) unsigned char smem[];
    cg::grid_group grid = cg::this_grid();
    LAS unsigned char* lds = (LAS unsigned char*)smem;
    unsigned char* ws = a.ws;
    const int G = gridDim.x, bx = blockIdx.x;

#ifndef PH_MASK
#define PH_MASK 0xFFFF
#endif
#ifndef REP_P0
#define REP_P0 1
#endif
#ifndef REP_P1
#define REP_P1 1
#endif
#ifndef REP_G1
#define REP_G1 1
#endif
#ifndef REP_G2
#define REP_G2 1
#endif
#ifndef REP_G3
#define REP_G3 1
#endif
#ifndef REP_G4
#define REP_G4 1
#endif
#ifndef REP_SYNC
#define REP_SYNC 1
#endif
#define GSYNC() do { for (int _r = 0; _r < REP_SYNC; ++_r) { if (a.use_cg) grid.sync(); else xcd_barrier(xbar); } } while (0)
    volatile LAS unsigned* xst = (volatile LAS unsigned*)(lds + LDS_BYTES - 64);
    if (threadIdx.x < 2) xst[threadIdx.x] = 0u;
    __syncthreads();
    const XcdBarrier xbar = xcd_barrier_post((unsigned*)(ws + WS_CTL), xst);
    for (int rep = 0; rep < REP_P0; ++rep) { phase0(a, smem); __syncthreads(); }
    GSYNC();
    for (int rep = 0; rep < REP_G1; ++rep) {
        pg8::Gemm g; g.A0 = g.A1 = (const bf16_t*)(ws + WS_H); g.B0 = g.B1 = (const bf16_t*)(ws + WS_W1T); g.K = D; g.mstride = 256;
        pg8::TileOrder S; S.init(M / 256, N1 / 256, G, bx, 0);
        Epi1 E{(bf16_t*)(ws + WS_U), (bf16_t*)(ws + WS_V), (bf16_t*)(ws + WS_ZB), (bf16_t*)(ws + WS_G), a.in[16], (float*)(ws + WS_VST)};
        pg8::gemm_phase(lds, g, S, E);
    }
    GSYNC();
    phase1(a, smem); __syncthreads();
    phase3(a, smem);
    GSYNC();
    for (int rep = 0; rep < REP_G2; ++rep) {
        pg8::Gemm g; g.A0 = (const bf16_t*)(ws + WS_U); g.A1 = (const bf16_t*)(ws + WS_H); g.B0 = (const bf16_t*)(ws + WS_WPA); g.B1 = (const bf16_t*)(ws + WS_WPB); g.K = D; g.mstride = 256;
        pg8::TileOrder S; S.init(M / 256, D / 256, G, bx, 1);
        Epi2 E{(const bf16_t*)(ws + WS_G), (bf16_t*)(ws + WS_V)};
        pg8::gemm_phase(lds, g, S, E);
    }
    GSYNC();
    for (int rep = 0; rep < REP_G3; ++rep) {
        pg8::Gemm g; g.A0 = g.A1 = (const bf16_t*)(ws + WS_V); g.B0 = g.B1 = (const bf16_t*)(ws + WS_WOUT); g.K = D; g.mstride = 256;
        pg8::TileOrder S; S.init(M / 256, D / 256, G, bx, 0);
        EpiRes<true> E{a.in[0], a.out, (bf16_t*)(ws + WS_H), (const float*)(ws + WS_MOD), 2 * D, a.in[18], (float*)(ws + WS_SS2), G == (M / 256) * (D / 256) ? (bf16_t*)(ws + WS_G) : nullptr};
        pg8::gemm_phase(lds, g, S, E);
    }
    GSYNC();
    for (int rep = 0; rep < REP_G4; ++rep) {
        pg8::Gemm g; g.A0 = g.A1 = (const bf16_t*)(ws + WS_H) - (size_t)2 * D; g.B0 = g.B1 = (const bf16_t*)(ws + WS_WUP); g.K = D; g.mstride = MT4;
        pg8::TileOrder S; S.init(NM4, NUP / 256, G, bx, 0);
        int pre = 0;
        { Unit pu; if (!S.next(6, pu)) {
              const int t = tid_opaque(); LAS float* rsBig = (LAS float*)(lds + LDS_HALO + 8192);
              if (t < 256) {
#pragma unroll
                  for (int i = 0; i < 6; ++i) if (S.next(i, pu)) { int gr = pu.pm * MT4 - 2 + t; gr = gr < 0 ? 0 : (gr > M - 1 ? M - 1 : gr);
                      const f32x4* p = (const f32x4*)((const float*)(ws + WS_SS2) + (size_t)gr * 16); const f32x4 st = (p[0] + p[1]) + (p[2] + p[3]);
                      rsBig[i * 256 + t] = __builtin_amdgcn_rsqf(((st[0] + st[1]) + (st[2] + st[3])) * (1.0f / D) + EPS); } }
              pre = 6; __syncthreads(); } }
        Epi4 E{(const float*)(ws + WS_SS2), (const float*)(ws + WS_CB), (const float*)(ws + WS_CW), (bf16_t*)(ws + WS_F), pre};
        pg8::gemm_phase(lds, g, S, E);
    }
    GSYNC();
    if (G == (M / 256) * (D / 256)) {
        pg8::Gemm g; g.A0 = g.A1 = (const bf16_t*)(ws + WS_F); g.B0 = g.B1 = (const bf16_t*)(ws + WS_WDN); g.K = DFF; g.mstride = 256;
        pg8::TileOrder S; S.init(M / 256, D / 256, G, bx, 0);
        EpiTail E{a.out, (const float*)(ws + WS_MOD), a.in[23], (float*)(ws + WS_VST), (unsigned*)(ws + WS_CTL + 16384), (const bf16_t*)(ws + WS_G)};
        pg8::gemm_phase(lds, g, S, E);
        return;
    }
    {
        pg8::Gemm g; g.A0 = g.A1 = (const bf16_t*)(ws + WS_F); g.B0 = g.B1 = (const bf16_t*)(ws + WS_WDN); g.K = DFF; g.mstride = 256;
        pg8::TileOrder S; S.init(M / 256, D / 256, G, bx, 0);
        EpiRes<false> E{a.out, a.out, nullptr, (const float*)(ws + WS_MOD), 5 * D, nullptr, (float*)(ws + WS_SS3), nullptr};
        pg8::gemm_phase(lds, g, S, E);
    }
    GSYNC();
    phase9(a);
}

extern "C" void kernel_launch(void* const* d_in, const int* in_sizes, int n_in, void* d_out, int out_size, void* d_ws, size_t ws_size, hipStream_t stream) {
    static int grid = 0;
    if (grid == 0) {
        int dev = 0, cus = 0, per_cu = 0;
        hipGetDevice(&dev);
        hipDeviceGetAttribute(&cus, hipDeviceAttributeMultiprocessorCount, dev);
        hipFuncSetAttribute((const void*)fwd_megakernel, hipFuncAttributeMaxDynamicSharedMemorySize, LDS_BYTES);
        hipOccupancyMaxActiveBlocksPerMultiprocessor(&per_cu, (const void*)fwd_megakernel, 512, LDS_BYTES);
        if (per_cu < 1) { fprintf(stderr, "kernel_launch: occupancy query says %d blocks per CU\n", per_cu); per_cu = 1; }
        grid = cus * per_cu;
    }
    if (hipMemsetAsync((char*)d_ws + WS_CTL, 0, CTL_BYTES, stream) != hipSuccess) fprintf(stderr, "kernel_launch: memset of the barrier words failed\n");
    Args a{};
    for (int i = 0; i < 24; ++i) a.in[i] = (const float*)d_in[i];
    a.out = (float*)d_out; a.ws = (unsigned char*)d_ws;
    void* args[] = {&a};
    hipError_t e = hipLaunchCooperativeKernel((const void*)fwd_megakernel, dim3(grid), dim3(512), args, LDS_BYTES, stream);
    if (e != hipSuccess) fprintf(stderr, "cooperative launch failed: %s (grid %d)\n", hipGetErrorString(e), grid);
}
```

```cpp
#include <hip/hip_runtime.h>
#include <hip/hip_cooperative_groups.h>
#include <cstdio>
#include <cstdint>
namespace cg = cooperative_groups;

#define LAS __attribute__((address_space(3)))
typedef unsigned short bf16_t;
typedef short bf16x8 __attribute__((ext_vector_type(8)));
typedef float f32x4 __attribute__((ext_vector_type(4)));
typedef float f32x2 __attribute__((ext_vector_type(2)));
typedef unsigned u32x4 __attribute__((ext_vector_type(4)));
typedef unsigned u32x2 __attribute__((ext_vector_type(2)));

constexpr int D = 1024, BATCH = 4, SEQ = 4096, M = BATCH * SEQ, DFF = 2816, NUP = 2 * DFF, NADA = 6 * D;
constexpr int N1 = 3 * D + 2 * D;
constexpr float EPS = 1e-6f;
constexpr int MT4 = 254, NM4 = 65;

constexpr size_t MiB = 1u << 20;
constexpr size_t WS_MOD = 0;
constexpr size_t WS_CB = 128 * 1024;
constexpr size_t WS_CW = 512 * 1024;
constexpr size_t WS_VST = 1 * MiB;
constexpr size_t WS_SS2 = 3 * MiB;
constexpr size_t WS_SS3 = 4 * MiB;
constexpr size_t WS_WSP = 5 * MiB;
constexpr size_t WS_WPOOL = 5 * MiB + 512 * 1024;
constexpr size_t WS_W1T = 6 * MiB;
constexpr size_t WS_WPA = 16 * MiB, WS_WPB = 18 * MiB, WS_WOUT = 20 * MiB;
constexpr size_t WS_WUP = 22 * MiB;
constexpr size_t WS_WDN = 33 * MiB;
constexpr size_t WS_H = 40 * MiB;
constexpr size_t WS_U = 72 * MiB;
constexpr size_t WS_V = 104 * MiB;
constexpr size_t WS_ZB = 136 * MiB;
constexpr size_t WS_G = 168 * MiB;
constexpr size_t WS_CTL = 240 * MiB, CTL_BYTES = 64 * 1024;
constexpr size_t WS_F = 72 * MiB;

constexpr int LDS_HALO = 131072;
constexpr int LDS_BYTES = 147456;

__device__ __forceinline__ unsigned cvt_pk_bf16(float lo, float hi) { unsigned r; asm("v_cvt_pk_bf16_f32 %0, %1, %2" : "=v"(r) : "v"(lo), "v"(hi)); return r; }
__device__ __forceinline__ float bf_lo(unsigned w) { return __uint_as_float(w << 16); }
__device__ __forceinline__ float bf_hi(unsigned w) { return __uint_as_float(w & 0xffff0000u); }
__device__ __forceinline__ float wave_sum(float v) {
#pragma unroll
    for (int o = 1; o < 64; o <<= 1) v += __shfl_xor(v, o);
    return v;
}
__device__ __forceinline__ int tid_opaque() { int t = threadIdx.x; asm volatile("" : "+v"(t)); return t; }
__device__ __forceinline__ float sigmoid_f(float x) { return __builtin_amdgcn_rcpf(1.0f + __builtin_amdgcn_exp2f(-1.4426950408889634f * x)); }
__device__ __forceinline__ f32x2 gelu_pk(f32x2 v) {
    const f32x2 av = __builtin_elementwise_abs(v), d = av * 0.2316418882f + 1.0f;
    f32x2 t; t.x = __builtin_amdgcn_rcpf(d.x); t.y = __builtin_amdgcn_rcpf(d.y);
    f32x2 q = t * 0.5307027145f + (-0.7265760135f); q = q * t + 0.7107068705f; q = q * t + (-0.142248368f); q = q * t + 0.127414796f; q = q * t;
    const f32x2 s = (v * v) * (-0.72134752044f);
    f32x2 e; e.x = __builtin_amdgcn_exp2f(s.x); e.y = __builtin_amdgcn_exp2f(s.y);
    const f32x2 m = v * (q * e), r = v - m;
    f32x2 o; o.x = v.x < 0.f ? m.x : r.x; o.y = v.y < 0.f ? m.y : r.y; return o;
}
__device__ __forceinline__ f32x4 gelu4(f32x4 v) { f32x2 a = gelu_pk((f32x2){v[0], v[1]}), b = gelu_pk((f32x2){v[2], v[3]}); return (f32x4){a.x, a.y, b.x, b.y}; }

namespace pg8 {
constexpr int BM = 256, BK = 64, HALF = 128, HTB = HALF * BK * 2, STAGE_BYTES = 8 * HTB, NXCD = 8, WGM = 2;
__host__ __device__ __forceinline__ int lds_byte(int r, int c) { const int st = (r >> 4) * 2 + (c >> 5), rr = r & 15, cc = c & 31, ob = rr * 64 + cc * 2; return st * 1024 + (ob ^ (((ob >> 9) & 1) << 5)); }
__host__ __device__ __forceinline__ void stage_rc(int b, int& R, int& C) { const int st = b / 1024, sb = b % 1024, swz = sb ^ (((sb >> 9) & 1) << 5); R = (st >> 1) * 16 + swz / 64; C = (st & 1) * 32 + (swz % 64) / 2; }
__host__ __device__ __forceinline__ int perm32(int rho) { const int n = rho >> 4, i = rho & 15; return 8 * (i >> 2) + 4 * n + (i & 3); }

struct Unit { int pm, pn, z, ord; };
struct Gemm { const bf16_t* A0; const bf16_t* A1; const bf16_t* B0; const bf16_t* B1; int K; int mstride; };

struct TileOrder {
    int nM, nN, nwg, G, c, ZS;
    __device__ void init(int nM_, int nN_, int G_, int c_, int ZS_) { nM = nM_; nN = nN_; nwg = nM * nN; G = G_; c = c_; ZS = ZS_; }
    __device__ bool next(int i, Unit& u) const {
        const int ti = i >> ZS; u.z = i & ((1 << ZS) - 1); u.ord = i;
        const long L = (long)ti * G + c; if (L >= nwg) return false;
        int wgid = (int)L; { const int q = nwg / NXCD, r = nwg % NXCD, xcd = wgid % NXCD, off = wgid / NXCD; wgid = (xcd < r ? xcd * (q + 1) : r * (q + 1) + (xcd - r) * q) + off; }
        const int nig = WGM * nN, gid = wgid / nig, fm = gid * WGM, gsz = (nM - fm) < WGM ? (nM - fm) : WGM;
        u.pm = fm + ((wgid % nig) % gsz); u.pn = (wgid % nig) / gsz; return true;
    }
};

template <class Epi, class Sched>
__device__ __forceinline__ void gemm_phase(LAS unsigned char* lds, const Gemm g, const Sched& S, const Epi& E) {
    const int tid = tid_opaque(), wid = __builtin_amdgcn_readfirstlane(tid >> 6), lane = tid & 63, wr = wid >> 2, wc = wid & 3, fr = lane & 15, fq = lane >> 4;
    const int K = g.K, nt = K / BK;
    unsigned voffA[2], voffB[2];
#pragma unroll
    for (int i = 0; i < 2; ++i) { int R, C; stage_rc(tid * 16 + i * 8192, R, C); const int Rb = Epi::PERM ? ((R & ~31) + perm32(R & 31)) : R;
        const int Ra = Epi::APERM ? ((R & ~63) + 4 * (R & 15) + ((R & 63) >> 4)) : R;
        voffA[i] = (unsigned)(Ra * K + C) * 2u; voffB[i] = (unsigned)(Rb * K + C) * 2u; }
    const size_t kstep = (size_t)(BK * 2);
    const size_t hstep = (size_t)HALF * K * 2;
    const size_t tstepB = 2 * hstep;
    const size_t tstepA = (size_t)g.mstride * K * 2;
    const unsigned ldsw = (unsigned)wid * 1024u;
    const int aoff = lds_byte(wr * 64 + fr, fq * 8), boff = lds_byte(wc * 32 + fr, fq * 8);
#define PG8_SA(b, h) (((b) * 2 + (h)) * HTB)
#define PG8_SB(b, h) ((4 + (b) * 2 + (h)) * HTB)
#define PG8_STAGE(bufoff, gbase, voff) do { _Pragma("unroll") for (int _i = 0; _i < 2; ++_i) \
        __builtin_amdgcn_global_load_lds((const unsigned*)((const char*)(gbase) + (voff)[_i]), (LAS unsigned*)(lds + (bufoff) + ldsw + _i * 8192), 16, 0, 0); } while (0)
#define PG8_LDA(dst, b, h) do { _Pragma("unroll") for (int m = 0; m < 4; ++m) _Pragma("unroll") for (int k = 0; k < 2; ++k) dst[m][k] = *(const LAS bf16x8*)(lds + PG8_SA(b, h) + aoff + m * 2048 + k * 1024); } while (0)
#define PG8_LDB(dst, b, h) do { _Pragma("unroll") for (int n = 0; n < 2; ++n) _Pragma("unroll") for (int k = 0; k < 2; ++k) dst[n][k] = *(const LAS bf16x8*)(lds + PG8_SB(b, h) + boff + n * 2048 + k * 1024); } while (0)
#define PG8_MMA(ai, bj, At, Bt) do { __builtin_amdgcn_s_setprio(1); _Pragma("unroll") for (int m = 0; m < 4; ++m) _Pragma("unroll") for (int n = 0; n < 2; ++n) _Pragma("unroll") for (int k = 0; k < 2; ++k) \
        acc[ai][bj][m][n] = __builtin_amdgcn_mfma_f32_16x16x32_bf16(Bt[n][k], At[m][k], acc[ai][bj][m][n], 0, 0, 0); __builtin_amdgcn_s_setprio(0); } while (0)
#define PG8_WAIT_V(n) asm volatile("s_waitcnt vmcnt(" #n ")" ::: "memory")
#define PG8_WAIT_L(n) asm volatile("s_waitcnt lgkmcnt(" #n ")" ::: "memory")
#define PG8_BAR __builtin_amdgcn_s_barrier()
#define PG8_SCHED __builtin_amdgcn_sched_barrier(0)
    Unit cur, nxt; int ui = 0;
    if (!S.next(0, cur)) return;
    f32x4 acc[2][2][4][2];
#pragma unroll
    for (int a = 0; a < 2; ++a)
#pragma unroll
        for (int b = 0; b < 2; ++b)
#pragma unroll
            for (int m = 0; m < 4; ++m)
#pragma unroll
                for (int n = 0; n < 2; ++n) acc[a][b][m][n] = (f32x4){0.f, 0.f, 0.f, 0.f};
    bf16x8 At[4][2], B0[2][2], B1[2][2];
    const char* cA = (const char*)(cur.z ? g.A1 : g.A0) + (size_t)cur.pm * tstepA; const char* cB = (const char*)(cur.z ? g.B1 : g.B0) + (size_t)cur.pn * tstepB;
    PG8_STAGE(PG8_SB(0, 0), cB, voffB); PG8_STAGE(PG8_SB(0, 1), cB + hstep, voffB); PG8_STAGE(PG8_SA(0, 0), cA, voffA); PG8_STAGE(PG8_SA(0, 1), cA + hstep, voffA);
    if (wr == 1) PG8_BAR;
    PG8_WAIT_V(2); PG8_BAR;
    PG8_STAGE(PG8_SB(1, 0), cB + kstep, voffB); PG8_STAGE(PG8_SA(1, 0), cA + kstep, voffA); PG8_STAGE(PG8_SB(1, 1), cB + hstep + kstep, voffB);
    PG8_WAIT_V(6); PG8_BAR;
    for (;;) {
        const bool has_next = S.next(ui + 1, nxt);
        const char* nA = has_next ? (const char*)(nxt.z ? g.A1 : g.A0) + (size_t)nxt.pm * tstepA : cA; const char* nB = has_next ? (const char*)(nxt.z ? g.B1 : g.B0) + (size_t)nxt.pn * tstepB : cB;
        for (int t = 0; t < nt; t += 2) {
            const bool last = (t == nt - 2);
            const char* a1 = cA + (size_t)(t + 1) * kstep;
            const char* a2 = last ? nA : cA + (size_t)(t + 2) * kstep; const char* b2 = last ? nB : cB + (size_t)(t + 2) * kstep;
            const char* a3 = a2 + kstep; const char* b3 = b2 + kstep;
            PG8_LDB(B0, 0, 0); PG8_LDB(B1, 0, 1); PG8_SCHED; PG8_LDA(At, 0, 0); PG8_STAGE(PG8_SA(1, 1), a1 + hstep, voffA);
            PG8_WAIT_V(8); PG8_WAIT_L(0); PG8_BAR; PG8_MMA(0, 0, At, B0); PG8_MMA(0, 1, At, B1); PG8_BAR; PG8_SCHED;
            PG8_LDA(At, 0, 1); PG8_STAGE(PG8_SB(0, 0), b2, voffB); PG8_STAGE(PG8_SB(0, 1), b2 + hstep, voffB); PG8_STAGE(PG8_SA(0, 0), a2, voffA);
            PG8_WAIT_V(8); PG8_WAIT_L(0); PG8_BAR; PG8_MMA(1, 0, At, B0); PG8_MMA(1, 1, At, B1); PG8_BAR; PG8_SCHED;
            PG8_LDB(B0, 1, 0); PG8_LDB(B1, 1, 1); PG8_SCHED; PG8_LDA(At, 1, 0); PG8_STAGE(PG8_SA(0, 1), a2 + hstep, voffA);
            PG8_WAIT_V(8); PG8_WAIT_L(0); PG8_BAR; PG8_MMA(0, 0, At, B0); PG8_MMA(0, 1, At, B1); PG8_BAR; PG8_SCHED;
            PG8_LDA(At, 1, 1); PG8_STAGE(PG8_SB(1, 0), b3, voffB); PG8_STAGE(PG8_SB(1, 1), b3 + hstep, voffB); PG8_STAGE(PG8_SA(1, 0), a3, voffA);
            PG8_WAIT_V(8); PG8_WAIT_L(0); PG8_BAR; PG8_MMA(1, 0, At, B0); PG8_MMA(1, 1, At, B1); PG8_BAR; PG8_SCHED;
        }
        if (wr == 0) PG8_BAR;
        E(acc, cur, wr, wc, fr, fq, lds);
        if (!has_next) break;
        if (!E.keep(cur)) {
#pragma unroll
        for (int a = 0; a < 2; ++a)
#pragma unroll
            for (int b = 0; b < 2; ++b)
#pragma unroll
                for (int m = 0; m < 4; ++m)
#pragma unroll
                    for (int n = 0; n < 2; ++n) acc[a][b][m][n] = (f32x4){0.f, 0.f, 0.f, 0.f};
        }
        cur = nxt; cA = nA; cB = nB; ++ui;
        if (wr == 1) PG8_BAR;
    }
    PG8_WAIT_V(0);
    PG8_BAR;
#undef PG8_SA
#undef PG8_SB
#undef PG8_STAGE
#undef PG8_LDA
#undef PG8_LDB
#undef PG8_MMA
#undef PG8_WAIT_V
#undef PG8_WAIT_L
#undef PG8_BAR
#undef PG8_SCHED
}
}
using pg8::Unit;

struct Epi1 {
    static constexpr bool PERM = true, APERM = false;
    bf16_t *U, *V, *ZB, *G; const float* bgate; float* vst;
    __device__ __forceinline__ bool keep(const Unit&) const { return false; }
    __device__ __forceinline__ void operator()(f32x4 (&acc)[2][2][4][2], const Unit& u, int wr, int wc, int fr, int fq, LAS unsigned char*) const {
        const int seg = u.pn >> 2;
        const int row0 = u.pm * 256 + wr * 64 + fr;
        bf16_t* base; int ld, colt;
        if (seg == 0) { base = U; ld = D; colt = u.pn * 256; }
        else if (seg == 1) { base = V; ld = D; colt = (u.pn - 4) * 256; }
        else if (seg == 2) { base = ZB; ld = D; colt = (u.pn - 8) * 256; }
        else { base = G; ld = 2 * D; colt = (u.pn - 12) * 256; }
        const int col0 = colt + wc * 32 + 8 * fq;
        f32x4 bv[2][2];
#pragma unroll
        for (int bj = 0; bj < 2; ++bj)
#pragma unroll
            for (int n = 0; n < 2; ++n) bv[bj][n] = (seg >= 3) ? *(const f32x4*)(bgate + col0 + bj * 128 + 4 * n) : (f32x4){0.f, 0.f, 0.f, 0.f};
#pragma unroll
        for (int ai = 0; ai < 2; ++ai)
#pragma unroll
            for (int m = 0; m < 4; ++m) {
                const int row = row0 + ai * 128 + m * 16;
                bf16_t* rowp = base + (size_t)row * ld + col0;
                float s = 0.f, q = 0.f;
#pragma unroll
                for (int bj = 0; bj < 2; ++bj) {
                    f32x4 v0 = acc[ai][bj][m][0] + bv[bj][0], v1 = acc[ai][bj][m][1] + bv[bj][1];
                    if (seg <= 1) { v0 = gelu4(v0); v1 = gelu4(v1); }
                    else if (seg == 3) {
#pragma unroll
                        for (int j = 0; j < 4; ++j) { v0[j] = sigmoid_f(v0[j]); v1[j] = sigmoid_f(v1[j]); }
                    }
                    else if (seg == 4) {
#pragma unroll
                        for (int j = 0; j < 4; ++j) { v0[j] = 1.0f + __builtin_amdgcn_exp2f(-1.4426950408889634f * fmaxf(v0[j], -80.0f)); v1[j] = 1.0f + __builtin_amdgcn_exp2f(-1.4426950408889634f * fmaxf(v1[j], -80.0f)); }
                    }
                    if (seg == 1) {
#pragma unroll
                        for (int j = 0; j < 4; ++j) { s += v0[j] + v1[j]; q += v0[j] * v0[j] + v1[j] * v1[j]; }
                    }
                    u32x4 w; w.x = cvt_pk_bf16(v0[0], v0[1]); w.y = cvt_pk_bf16(v0[2], v0[3]); w.z = cvt_pk_bf16(v1[0], v1[1]); w.w = cvt_pk_bf16(v1[2], v1[3]);
                    *(u32x4*)(rowp + bj * 128) = w;
                }
                if (seg == 1) {
                    s += __shfl_xor(s, 16); s += __shfl_xor(s, 32); q += __shfl_xor(q, 16); q += __shfl_xor(q, 32);
                    if (fq == 0) *(f32x2*)(vst + ((size_t)row * 16 + (u.pn - 4) * 4 + wc) * 2) = (f32x2){s, q};
                }
            }
    }
};
struct Epi2 {
    static constexpr bool PERM = true, APERM = false;
    const bf16_t* G; bf16_t* O;
    __device__ __forceinline__ bool keep(const Unit& u) const { return u.z == 0; }
    __device__ __forceinline__ void operator()(f32x4 (&acc)[2][2][4][2], const Unit& u, int wr, int wc, int fr, int fq, LAS unsigned char*) const {
        const int row0 = u.pm * 256 + wr * 64 + fr, col0 = u.pn * 256 + wc * 32 + 8 * fq;
        if (u.z == 0) {
#pragma unroll
            for (int ai = 0; ai < 2; ++ai)
#pragma unroll
                for (int m = 0; m < 4; ++m) {
                    const bf16_t* gp = G + (size_t)(row0 + ai * 128 + m * 16) * (2 * D) + col0;
#pragma unroll
                    for (int bj = 0; bj < 2; ++bj) {
                        const u32x4 ga4 = *(const u32x4*)(gp + bj * 128), gb4 = *(const u32x4*)(gp + D + bj * 128);
#pragma unroll
                        for (int n = 0; n < 2; ++n) {
                            const unsigned gax = n ? ga4.z : ga4.x, gay = n ? ga4.w : ga4.y, gbx = n ? gb4.z : gb4.x, gby = n ? gb4.w : gb4.y;
                            f32x4 r;
                            r[0] = bf_lo(gax) * bf_lo(gbx); r[1] = bf_hi(gax) * bf_hi(gbx);
                            r[2] = bf_lo(gay) * bf_lo(gby); r[3] = bf_hi(gay) * bf_hi(gby);
                            acc[ai][bj][m][n] *= r;
                        }
                    }
                    if (m & 1) asm volatile("" ::: "memory");
                }
        } else {
#pragma unroll
            for (int ai = 0; ai < 2; ++ai)
#pragma unroll
                for (int m = 0; m < 4; ++m) {
                    const size_t row = (size_t)(row0 + ai * 128 + m * 16);
                    const bf16_t* gp = G + row * (2 * D) + D + col0;
#pragma unroll
                    for (int bj = 0; bj < 2; ++bj) {
                        const u32x4 gb = *(const u32x4*)(gp + bj * 128);
                        const f32x4 a0 = acc[ai][bj][m][0], a1 = acc[ai][bj][m][1];
                        u32x4 w;
                        w.x = cvt_pk_bf16(a0[0] * __builtin_amdgcn_rcpf(bf_lo(gb.x)), a0[1] * __builtin_amdgcn_rcpf(bf_hi(gb.x)));
                        w.y = cvt_pk_bf16(a0[2] * __builtin_amdgcn_rcpf(bf_lo(gb.y)), a0[3] * __builtin_amdgcn_rcpf(bf_hi(gb.y)));
                        w.z = cvt_pk_bf16(a1[0] * __builtin_amdgcn_rcpf(bf_lo(gb.z)), a1[1] * __builtin_amdgcn_rcpf(bf_hi(gb.z)));
                        w.w = cvt_pk_bf16(a1[2] * __builtin_amdgcn_rcpf(bf_lo(gb.w)), a1[3] * __builtin_amdgcn_rcpf(bf_hi(gb.w)));
                        *(u32x4*)(O + row * D + col0 + bj * 128) = w;
                    }
                    asm volatile("" ::: "memory");
                }
        }
    }
};
template <bool WITH_A2> struct EpiRes {
    static constexpr bool PERM = false, APERM = false;
    const float* xi; float* xo; bf16_t* a2; const float* mod; int gate_off; const float* g2; float* ss; bf16_t* x1b;
    __device__ __forceinline__ bool keep(const Unit&) const { return false; }
    __device__ __forceinline__ void operator()(f32x4 (&acc)[2][2][4][2], const Unit& u, int wr, int wc, int fr, int fq, LAS unsigned char*) const {
        const int b = (u.pm * 256) >> 12;
        const int row0 = u.pm * 256 + wr * 64 + fr, col0 = u.pn * 256 + wc * 32 + 4 * fq;
        f32x4 gt[2][2], sc[2][2];
#pragma unroll
        for (int bj = 0; bj < 2; ++bj)
#pragma unroll
            for (int n = 0; n < 2; ++n) {
                const int c = col0 + bj * 128 + n * 16;
                gt[bj][n] = *(const f32x4*)(mod + b * NADA + gate_off + c);
                if (WITH_A2) sc[bj][n] = *(const f32x4*)(g2 + c) * (*(const f32x4*)(mod + b * NADA + 4 * D + c) + 1.0f);
            }
#pragma unroll
        for (int ai = 0; ai < 2; ++ai)
#pragma unroll
            for (int m = 0; m < 4; ++m) {
                const int row = row0 + ai * 128 + m * 16; const size_t off = (size_t)row * D + col0;
                float q = 0.f;
#pragma unroll
                for (int bj = 0; bj < 2; ++bj) {
                    u32x2 wn[2], wx[2];
#pragma unroll
                    for (int n = 0; n < 2; ++n) {
                        const f32x4 xv = *(const f32x4*)(xi + off + bj * 128 + n * 16);
                        const f32x4 v = xv + gt[bj][n] * acc[ai][bj][m][n];
                        if (WITH_A2 && x1b) { wx[n].x = cvt_pk_bf16(v[0], v[1]); wx[n].y = cvt_pk_bf16(v[2], v[3]); }
                        else *(f32x4*)(xo + off + bj * 128 + n * 16) = v;
                        q += (v[0] * v[0] + v[1] * v[1]) + (v[2] * v[2] + v[3] * v[3]);
                        if (WITH_A2) { const f32x4 a = v * sc[bj][n]; wn[n].x = cvt_pk_bf16(a[0], a[1]); wn[n].y = cvt_pk_bf16(a[2], a[3]); }
                    }
                    if (WITH_A2 && x1b) {
                        const auto rx = __builtin_amdgcn_permlane16_swap(wx[0].x, wx[1].x, false, false), ry = __builtin_amdgcn_permlane16_swap(wx[0].y, wx[1].y, false, false);
                        *(u32x4*)(x1b + off + bj * 128 + ((fq & 1) ? 12 : 0)) = (u32x4){rx[0], ry[0], rx[1], ry[1]};
                    }
                    if (WITH_A2) {
                        const auto rx = __builtin_amdgcn_permlane16_swap(wn[0].x, wn[1].x, false, false), ry = __builtin_amdgcn_permlane16_swap(wn[0].y, wn[1].y, false, false);
                        const u32x4 w16 = (u32x4){rx[0], ry[0], rx[1], ry[1]};
                        const int cofs = (fq & 1) ? 16 + 4 * (fq - 1) - 4 * fq : 0;
                        *(u32x4*)(a2 + off + bj * 128 + cofs) = w16;
                    }
                }
                q += __shfl_xor(q, 16); q += __shfl_xor(q, 32);
                if (fq == 0) ss[(size_t)row * 16 + u.pn * 4 + wc] = q;
            }
    }
};
struct EpiTail {
    static constexpr bool PERM = false, APERM = false;
    float* xio; const float* mod; const float* gf; float* xbuf; unsigned* cnt; const bf16_t* x1b;
    __device__ __forceinline__ bool keep(const Unit&) const { return false; }
    __device__ __forceinline__ void operator()(f32x4 (&acc)[2][2][4][2], const Unit& u, int wr, int wc, int fr, int fq, LAS unsigned char* lds) const {
        const int b = (u.pm * 256) >> 12, tidx = tid_opaque();
        const int row0 = u.pm * 256 + wr * 64 + fr, col0 = u.pn * 256 + wc * 32 + 4 * fq;
        LAS float* P = (LAS float*)(lds + LDS_HALO);
        LAS float* S = (LAS float*)(lds + LDS_HALO + 4096);
        {
            f32x4 gt[2][2];
#pragma unroll
            for (int bj = 0; bj < 2; ++bj)
#pragma unroll
                for (int n = 0; n < 2; ++n) gt[bj][n] = *(const f32x4*)(mod + b * NADA + 5 * D + col0 + bj * 128 + n * 16);
#pragma unroll
            for (int ai = 0; ai < 2; ++ai)
#pragma unroll
                for (int m = 0; m < 4; ++m) {
                    const size_t off = (size_t)(row0 + ai * 128 + m * 16) * D + col0;
                    float q = 0.f;
#pragma unroll
                    for (int bj = 0; bj < 2; ++bj) {
                        const u32x4 L = *(const u32x4*)(x1b + off + bj * 128 + ((fq & 1) ? 12 : 0));
                        const auto rx = __builtin_amdgcn_permlane16_swap(L.x, L.z, false, false), ry = __builtin_amdgcn_permlane16_swap(L.y, L.w, false, false);
#pragma unroll
                        for (int n = 0; n < 2; ++n) {
                            const f32x4 xv = (f32x4){bf_lo(rx[n]), bf_hi(rx[n]), bf_lo(ry[n]), bf_hi(ry[n])};
                            const f32x4 v = xv + gt[bj][n] * acc[ai][bj][m][n];
                            acc[ai][bj][m][n] = v;
                            q += (v[0] * v[0] + v[1] * v[1]) + (v[2] * v[2] + v[3] * v[3]);
                        }
                    }
                    q += __shfl_xor(q, 16); q += __shfl_xor(q, 32);
                    if (fq == 0) P[(ai * 128 + wr * 64 + m * 16 + fr) * 4 + wc] = q;
                    asm volatile("" ::: "memory");
                }
        }
        asm volatile("s_waitcnt lgkmcnt(0)" ::: "memory"); __builtin_amdgcn_s_barrier(); asm volatile("" ::: "memory");
        if (tidx < 256) { const f32x4 p = *(const LAS f32x4*)(P + tidx * 4);
            __hip_atomic_store(xbuf + (size_t)(u.pm * 256 + tidx) * 4 + u.pn, (p[0] + p[1]) + (p[2] + p[3]), __ATOMIC_RELAXED, __HIP_MEMORY_SCOPE_AGENT); }
        asm volatile("s_waitcnt vmcnt(0)" ::: "memory"); __builtin_amdgcn_s_barrier(); asm volatile("" ::: "memory");
        if (tidx < 64) {
            if (tidx == 0) __hip_atomic_fetch_add(cnt + 64 * u.pm, 1u, __ATOMIC_RELAXED, __HIP_MEMORY_SCOPE_AGENT);
            unsigned sp = 0;
            while ((unsigned)__builtin_amdgcn_readfirstlane(__hip_atomic_load(cnt + 64 * u.pm, __ATOMIC_RELAXED, __HIP_MEMORY_SCOPE_AGENT)) < 4u) { __builtin_amdgcn_s_sleep(2); if (++sp > (1u << 22)) break; }
            __builtin_amdgcn_fence(__ATOMIC_ACQUIRE, "agent");
            asm volatile("s_waitcnt vmcnt(0)" ::: "memory");
        }
        __builtin_amdgcn_s_barrier(); asm volatile("" ::: "memory");
        if (tidx < 256) { const float* xp = xbuf + (size_t)(u.pm * 256 + tidx) * 4; float t = 0.f;
#pragma unroll
            for (int j = 0; j < 4; ++j) t += __hip_atomic_load(xp + j, __ATOMIC_RELAXED, __HIP_MEMORY_SCOPE_AGENT);
            S[tidx] = __builtin_amdgcn_rsqf(t * (1.0f / D) + EPS); }
        asm volatile("s_waitcnt vmcnt(0) lgkmcnt(0)" ::: "memory"); __builtin_amdgcn_s_barrier(); asm volatile("" ::: "memory");
        f32x4 gv[2][2];
#pragma unroll
        for (int bj = 0; bj < 2; ++bj)
#pragma unroll
            for (int n = 0; n < 2; ++n) gv[bj][n] = *(const f32x4*)(gf + col0 + bj * 128 + n * 16);
#pragma unroll
        for (int ai = 0; ai < 2; ++ai)
#pragma unroll
            for (int m = 0; m < 4; ++m) {
                const float rstd = S[ai * 128 + wr * 64 + m * 16 + fr];
                const size_t off = (size_t)(row0 + ai * 128 + m * 16) * D + col0;
#pragma unroll
                for (int bj = 0; bj < 2; ++bj)
#pragma unroll
                    for (int n = 0; n < 2; ++n) *(f32x4*)(xio + off + bj * 128 + n * 16) = acc[ai][bj][m][n] * rstd * gv[bj][n];
            }
    }
};
template <int CTRL> __device__ __forceinline__ float dpp_old(float old, float v) { return __int_as_float(__builtin_amdgcn_update_dpp(__float_as_int(old), __float_as_int(v), CTRL, 0xf, 0xf, false)); }
template <int CTRL> __device__ __forceinline__ float dpp_ror(float v) { return __int_as_float(__builtin_amdgcn_update_dpp(0, __float_as_int(v), CTRL, 0xf, 0xf, false)); }
struct Epi4 {
    static constexpr bool PERM = true, APERM = true;
    const float* ss2; const float* cb; const float* cw; bf16_t* F; int pre;
    __device__ __forceinline__ bool keep(const Unit&) const { return false; }
    __device__ __forceinline__ void operator()(f32x4 (&acc)[2][2][4][2], const Unit& u, int wr, int wc, int fr, int fq, LAS unsigned char* lds) const {
        const int grow0 = u.pm * MT4 - 2;
        LAS float* hal = (LAS float*)(lds + LDS_HALO);
        LAS float* rsT = (LAS float*)(lds + LDS_HALO + 8192) + (pre ? u.ord * 256 : 0);
        LAS int* infT = (LAS int*)(lds + LDS_HALO + 8192 + 6144);
        const int s0 = grow0 & (SEQ - 1);
        const bool fast = grow0 >= 0 && s0 >= 2 && s0 + 255 < SEQ && grow0 + 255 < M;
        if (pre == 0 || !fast) {
            const int tidx = tid_opaque();
            if (tidx < 256) {
                const int lr = tidx, gr = grow0 + lr, grc = gr < 0 ? 0 : (gr > M - 1 ? M - 1 : gr);
                if (pre == 0) { const f32x4* p = (const f32x4*)(ss2 + (size_t)grc * 16);
                    const f32x4 st = (p[0] + p[1]) + (p[2] + p[3]);
                    rsT[lr] = __builtin_amdgcn_rsqf(((st[0] + st[1]) + (st[2] + st[3])) * (1.0f / D) + EPS); }
                const int sq = grc & (SEQ - 1), b = grc >> 12, sidx = sq < 2 ? sq : 2;
                infT[lr] = (sidx * 4 + b) | (sq >= 1 ? 16 : 0) | (sq >= 2 ? 32 : 0) | ((lr >= 2 && gr < M) ? 64 : 0);
            }
            asm volatile("s_waitcnt lgkmcnt(0)" ::: "memory"); __builtin_amdgcn_s_barrier(); asm volatile("" ::: "memory");
        }
#pragma unroll
        for (int ai = 0; ai < 2; ++ai)
#pragma unroll
            for (int m = 0; m < 4; ++m) {
                const float rstd = rsT[ai * 128 + wr * 64 + 4 * fr + m];
#pragma unroll
                for (int bj = 0; bj < 2; ++bj)
#pragma unroll
                    for (int n = 0; n < 2; ++n) acc[ai][bj][m][n] *= rstd;
            }
        const int ccol = wc * 32 + 8 * fq;
        if (fr == 15) {
#pragma unroll
            for (int ai = 0; ai < 2; ++ai)
#pragma unroll
                for (int bj = 0; bj < 2; ++bj)
#pragma unroll
                    for (int n = 0; n < 2; ++n) {
                        *(LAS f32x4*)(hal + ((ai * 2 + wr) * 2 + 0) * 256 + bj * 128 + ccol + 4 * n) = acc[ai][bj][2][n];
                        *(LAS f32x4*)(hal + ((ai * 2 + wr) * 2 + 1) * 256 + bj * 128 + ccol + 4 * n) = acc[ai][bj][3][n];
                    }
        }
        asm volatile("s_waitcnt lgkmcnt(0)" ::: "memory"); __builtin_amdgcn_s_barrier(); asm volatile("" ::: "memory");
        if (fast) conv<true>(acc, u, wr, wc, fr, fq, hal, infT, grow0);
        else conv<false>(acc, u, wr, wc, fr, fq, hal, infT, grow0);
    }
    template <bool FAST> __device__ __forceinline__ void conv(f32x4 (&acc)[2][2][4][2], const Unit& u, int wr, int wc, int fr, int fq, LAS float* hal, LAS int* infT, int grow0) const {
        const int ccol = wc * 32 + 8 * fq;
        const int ncol0 = u.pn * 256 + ccol;
        const int cidx = 8 + (grow0 >> 12);
        u32x2 pk0[2][4];
#pragma unroll
        for (int n = 0; n < 2; ++n) {
            f32x4 w0[2], w1[2], w2[2], cbc[2];
#pragma unroll
            for (int bj = 0; bj < 2; ++bj) { const int c = ncol0 + bj * 128 + 4 * n; w0[bj] = *(const f32x4*)(cw + c); w1[bj] = *(const f32x4*)(cw + NUP + c); w2[bj] = *(const f32x4*)(cw + 2 * NUP + c);
                if (FAST) cbc[bj] = *(const f32x4*)(cb + (size_t)cidx * NUP + c); }
#pragma unroll
            for (int ai = 0; ai < 2; ++ai) {
                const int grp = ai * 2 + wr;
                f32x4 P3[2], P2[2];
#pragma unroll
                for (int bj = 0; bj < 2; ++bj) {
                    f32x4 c1, c2;
                    if (grp > 0) { c1 = *(const LAS f32x4*)(hal + ((grp - 1) * 2 + 1) * 256 + bj * 128 + ccol + 4 * n); c2 = *(const LAS f32x4*)(hal + ((grp - 1) * 2 + 0) * 256 + bj * 128 + ccol + 4 * n); }
                    else { c1 = (f32x4){0.f, 0.f, 0.f, 0.f}; c2 = (f32x4){0.f, 0.f, 0.f, 0.f}; }
#pragma unroll
                    for (int j = 0; j < 4; ++j) { P3[bj][j] = dpp_old<0x111>(c1[j], acc[ai][bj][3][n][j]); P2[bj][j] = dpp_old<0x111>(c2[j], acc[ai][bj][2][n][j]); }
                }
#pragma unroll
                for (int m = 0; m < 4; ++m) {
                    const int lr = ai * 128 + wr * 64 + 4 * fr + m;
                    int info = 0; if (!FAST) info = infT[lr];
                    f32x4 val[2];
#pragma unroll
                    for (int bj = 0; bj < 2; ++bj) {
                        const f32x4 Xm = acc[ai][bj][m][n];
                        f32x4 S1 = m == 0 ? P3[bj] : acc[ai][bj][m > 0 ? m - 1 : 0][n];
                        f32x4 S2 = m == 0 ? P2[bj] : (m == 1 ? P3[bj] : acc[ai][bj][m > 1 ? m - 2 : 0][n]);
                        f32x4 cbv;
                        if (FAST) cbv = cbc[bj];
                        else { cbv = *(const f32x4*)(cb + (size_t)(info & 15) * NUP + ncol0 + bj * 128 + 4 * n);
#pragma unroll
                            for (int j = 0; j < 4; ++j) { S1[j] = (info & 16) ? S1[j] : 0.f; S2[j] = (info & 32) ? S2[j] : 0.f; } }
                        val[bj] = cbv + w2[bj] * Xm + w1[bj] * S1 + w0[bj] * S2;
                    }
                    f32x4 f;
#pragma unroll
                    for (int j = 0; j < 4; ++j) f[j] = val[0][j] * sigmoid_f(val[0][j]) * val[1][j];
                    u32x2 w; w.x = cvt_pk_bf16(f[0], f[1]); w.y = cvt_pk_bf16(f[2], f[3]);
                    bool st = lr >= 2; if (!FAST) st = (info & 64) != 0;
                    if (n == 0) pk0[ai][m] = w;
                    else if (st) *(u32x4*)(F + (size_t)(grow0 + lr) * DFF + u.pn * 128 + ccol) = (u32x4){pk0[ai][m].x, pk0[ai][m].y, w.x, w.y};
                }
                if (!FAST) asm volatile("" ::: "memory");
            }
        }
    }
};


#define XB_TMO      128
#define XB_XCNT(j)  (256  + 64 * (j))
#define XB_XSUB(j)  (1280 + 64 * (j))
#define XB_XGEN(j)  (2304 + 64 * (j))
#define XB_TOP      3328
#define XB_TOPGEN   3392
#define XCD_BAR_WORDS 3456
#define XB_SPIN_CAP (1u << 22)
__device__ __forceinline__ unsigned xb_ld(unsigned* p)              { return __hip_atomic_load(p, __ATOMIC_RELAXED, __HIP_MEMORY_SCOPE_AGENT); }
__device__ __forceinline__ unsigned xb_add(unsigned* p, unsigned v) { return __hip_atomic_fetch_add(p, v, __ATOMIC_RELAXED, __HIP_MEMORY_SCOPE_AGENT); }
__device__ __forceinline__ unsigned xb_xcc_id() { return (unsigned)__builtin_amdgcn_s_getreg((3 << 11) | 20) & 0xFu; }
#define XB_SPIN(cond, bar) do { unsigned _sp = 0; while (cond) { __builtin_amdgcn_s_sleep(1); \
    if ((++_sp & 255u) == 0u) { if (xb_ld(&(bar)[XB_TMO])) break; if (_sp > XB_SPIN_CAP) { atomicAdd(&(bar)[XB_TMO], 1u); break; } } } } while (0)
struct XcdBarrier { unsigned* bar; unsigned x; volatile LAS unsigned* st; };
__device__ __forceinline__ XcdBarrier xcd_barrier_post(unsigned* bar, volatile LAS unsigned* st) {
    XcdBarrier b; b.bar = bar; b.x = xb_xcc_id(); b.st = st;
    if (threadIdx.x == 0) (void)xb_add(&bar[XB_XCNT(b.x)], 1u);
    return b;
}
__device__ __forceinline__ void xcd_barrier_complete(unsigned* bar, unsigned x, unsigned& nloc, unsigned& nx) {
    const unsigned G = gridDim.x * gridDim.y * gridDim.z;
    unsigned sum, cnt, mine, sp = 0u;
    for (;;) {
        sum = 0u; cnt = 0u; mine = 0u;
#pragma unroll
        for (unsigned j = 0; j < 16; ++j) { const unsigned c = xb_ld(&bar[XB_XCNT(j)]); sum += c; cnt += (c > 0u) ? 1u : 0u; mine = (j == x) ? c : mine; }
        if (sum == G) break;
        __builtin_amdgcn_s_sleep(1);
        if ((++sp & 255u) == 0u) { if (xb_ld(&bar[XB_TMO])) break; if (sp > XB_SPIN_CAP) { atomicAdd(&bar[XB_TMO], 1u); break; } }
    }
    nloc = mine > 0u ? mine : 1u; nx = cnt > 0u ? cnt : 1u;
}
__device__ __forceinline__ void xcd_barrier(const XcdBarrier& b) {
    asm volatile("s_waitcnt vmcnt(0)" ::: "memory");
    __syncthreads();
    if (threadIdx.x == 0) {
        unsigned* bar = b.bar;
        __builtin_amdgcn_s_waitcnt(0);
        unsigned nloc = b.st[0], nx = b.st[1];
        if (nloc == 0u) { xcd_barrier_complete(bar, b.x, nloc, nx); b.st[0] = nloc; b.st[1] = nx; }
        const unsigned old = xb_add(&bar[XB_XSUB(b.x)], 1u);
        const unsigned gen = old / nloc;
        if (old + 1u == (gen + 1u) * nloc) {
            __builtin_amdgcn_fence(__ATOMIC_RELEASE, "agent");
            asm volatile("s_waitcnt vmcnt(0)" ::: "memory");
            const unsigned og = xb_add(&bar[XB_TOP], 1u);
            const unsigned tg = og / nx;
            if (og + 1u == (tg + 1u) * nx) xb_add(&bar[XB_TOPGEN], 1u);
            else XB_SPIN(xb_ld(&bar[XB_TOPGEN]) == tg, bar);
            __builtin_amdgcn_fence(__ATOMIC_ACQUIRE, "agent");
            xb_add(&bar[XB_XGEN(b.x)], 1u);
            asm volatile("s_waitcnt vmcnt(0)" ::: "memory");
        } else {
            XB_SPIN(xb_ld(&bar[XB_XGEN(b.x)]) == gen, bar);
            __builtin_amdgcn_fence(__ATOMIC_ACQUIRE, "agent");
            asm volatile("s_waitcnt vmcnt(0)" ::: "memory");
        }
    }
    __syncthreads();
}

struct Args { const float* in[24]; float* out; unsigned char* ws; int use_cg; int pad; };

__device__ __forceinline__ void transpose_item(const float* W, int K, int N, bf16_t* WT, int dst_row0, int k0, int n0, float* scr, int lane) {
    {   f32x4 v[8];
#pragma unroll
        for (int i = 0; i < 8; ++i) v[i] = __builtin_nontemporal_load((const f32x4*)(W + (size_t)(k0 + 8 * i + (lane >> 3)) * N + n0 + (lane & 7) * 4));
#pragma unroll
        for (int i = 0; i < 8; ++i) { float* d = scr + (8 * i + (lane >> 3)) * 33 + (lane & 7) * 4; d[0] = v[i][0]; d[1] = v[i][1]; d[2] = v[i][2]; d[3] = v[i][3]; }
    }
    asm volatile("s_waitcnt lgkmcnt(0)" ::: "memory");
    const int c = lane & 7;
#pragma unroll
    for (int j = 0; j < 4; ++j) { const int n = (lane >> 3) + 8 * j; const float* s = scr + (8 * c) * 33 + n;
        u32x4 o; o.x = cvt_pk_bf16(s[0 * 33], s[1 * 33]); o.y = cvt_pk_bf16(s[2 * 33], s[3 * 33]); o.z = cvt_pk_bf16(s[4 * 33], s[5 * 33]); o.w = cvt_pk_bf16(s[6 * 33], s[7 * 33]);
        *(u32x4*)(WT + (size_t)(dst_row0 + n) * K + k0 + 8 * c) = o; }
    asm volatile("s_waitcnt lgkmcnt(0)" ::: "memory");
}
__device__ __forceinline__ void phase0(const Args& a, unsigned char* smem) {
    const int tid = tid_opaque(), lane = tid & 63, wave = tid >> 6, G = gridDim.x;
    unsigned char* ws = a.ws;
    float* sc = (float*)(smem + 72 * 1024);
    float* red = (float*)(smem + 88 * 1024);
    const float* c = a.in[1];
    for (int i = tid; i < 4 * D; i += 512) { const float v = c[i]; sc[i] = v * sigmoid_f(v); }
    __syncthreads();
    const float* w_ada = a.in[2]; const float* b_ada = a.in[3]; float* mod = (float*)(ws + WS_MOD);
    unsigned* modctr = (unsigned*)(ws + WS_CTL + 49152);
    for (int nc = blockIdx.x; nc < NADA / 24; nc += G) {
        const int n0 = nc * 24, col = lane & 31, par = lane >> 5; const bool act = col < 24;
        float a0 = 0.f, a1 = 0.f, a2 = 0.f, a3 = 0.f;
#pragma unroll 8
        for (int i = 0; i < 64; ++i) { const int k = wave * 128 + 2 * i + par; const float w = act ? __builtin_nontemporal_load(w_ada + (size_t)k * NADA + n0 + col) : 0.f;
            a0 += sc[k] * w; a1 += sc[D + k] * w; a2 += sc[2 * D + k] * w; a3 += sc[3 * D + k] * w; }
        a0 += __shfl_xor(a0, 32); a1 += __shfl_xor(a1, 32); a2 += __shfl_xor(a2, 32); a3 += __shfl_xor(a3, 32);
        if (lane < 32) { red[(wave * 4 + 0) * 32 + col] = a0; red[(wave * 4 + 1) * 32 + col] = a1; red[(wave * 4 + 2) * 32 + col] = a2; red[(wave * 4 + 3) * 32 + col] = a3; }
        __syncthreads();
        if (tid < 128) { const int b = tid >> 5, cc = tid & 31;
            if (cc < 24) { float s = b_ada[n0 + cc];
#pragma unroll
                for (int w = 0; w < 8; ++w) s += red[(w * 4 + b) * 32 + cc];
                __hip_atomic_store(mod + b * NADA + n0 + cc, s, __ATOMIC_RELAXED, __HIP_MEMORY_SCOPE_AGENT); } }
        asm volatile("s_waitcnt vmcnt(0)" ::: "memory");
        __syncthreads();
        if (tid == 0) __hip_atomic_fetch_add(modctr, 1u, __ATOMIC_RELAXED, __HIP_MEMORY_SCOPE_AGENT);
    }
    float* scr = (float*)(smem + wave * 17408);
    const int gw = blockIdx.x * 8 + wave, NGW = G * 8;
    constexpr int I_IN = 16 * 64, I_GATE = 16 * 64, I_SQ = 16 * 32, I_UP = 16 * 176, I_DN = 44 * 32, I_PC = 4 * 8 * 64;
    constexpr int NITEMS = I_IN + I_GATE + 3 * I_SQ + I_UP + I_DN + I_PC;
    const int nj = (NITEMS - gw + NGW - 1) / NGW; const bool revo = ((wave >> 2) & 1) == 0;
    for (int jj = 0; jj < nj; ++jj) {
        const int it = gw + NGW * (revo ? nj - 1 - jj : jj);
        int r = it;
        if (r < I_IN) { const int nb = 64, kb = r / nb, n0 = (r % nb) * 32; transpose_item(a.in[5], D, 3 * D, (bf16_t*)(ws + WS_W1T), n0, kb * 64, n0, scr, lane); continue; } r -= I_IN;
        if (r < I_GATE) { const int nb = 64, kb = r / nb, n0 = (r % nb) * 32; transpose_item(a.in[15], D, 2 * D, (bf16_t*)(ws + WS_W1T), 3 * D + n0, kb * 64, n0, scr, lane); continue; } r -= I_GATE;
        if (r < I_SQ) { const int kb = r / 32, n0 = (r % 32) * 32; transpose_item(a.in[13], D, D, (bf16_t*)(ws + WS_WPA), n0, kb * 64, n0, scr, lane); continue; } r -= I_SQ;
        if (r < I_SQ) { const int kb = r / 32, n0 = (r % 32) * 32; transpose_item(a.in[14], D, D, (bf16_t*)(ws + WS_WPB), n0, kb * 64, n0, scr, lane); continue; } r -= I_SQ;
        if (r < I_SQ) { const int kb = r / 32, n0 = (r % 32) * 32; transpose_item(a.in[17], D, D, (bf16_t*)(ws + WS_WOUT), n0, kb * 64, n0, scr, lane); continue; } r -= I_SQ;
        if (r < I_UP) { const int nb = 176, kb = r / nb, n0 = (r % nb) * 32; const int half = n0 >= DFF ? 1 : 0, j = n0 - half * DFF;
            transpose_item(a.in[19], D, NUP, (bf16_t*)(ws + WS_WUP), (j >> 7) * 256 + half * 128 + (j & 127), kb * 64, n0, scr, lane); continue; } r -= I_UP;
        if (r < I_DN) { const int kb = r / 32, n0 = (r % 32) * 32; transpose_item(a.in[22], DFF, D, (bf16_t*)(ws + WS_WDN), n0, kb * 64, n0, scr, lane); continue; } r -= I_DN;
        {
            const int g = r >> 9, q = r & 511, n0 = (q >> 6) * 32, k0 = (q & 63) * 16, nn = lane & 31, kh = lane >> 5;
            float* At = (float*)(smem + wave * 17408);
            { const float* Ag = a.in[5] + (size_t)k0 * (3 * D) + 2 * D + g * 256; f32x4 av[16];
#pragma unroll
              for (int i = 0; i < 16; ++i) av[i] = *(const f32x4*)(Ag + (size_t)i * (3 * D) + 4 * lane);
#pragma unroll
              for (int i = 0; i < 16; ++i) *(f32x4*)(At + i * 260 + 4 * lane) = av[i]; }
            asm volatile("s_waitcnt lgkmcnt(0)" ::: "memory");
            const float* Bp = a.in[10] + (size_t)g * 65536 + n0 + nn;
            const float* Ar = At + (kh * 8) * 260;
            float accp[8];
#pragma unroll
            for (int i = 0; i < 8; ++i) accp[i] = 0.f;
#pragma unroll 2
            for (int c0 = 0; c0 < 256; c0 += 32) {
                float bv[32];
#pragma unroll
                for (int j = 0; j < 32; ++j) bv[j] = Bp[(size_t)(c0 + j) * 256];
#pragma unroll
                for (int i = 0; i < 8; ++i)
#pragma unroll
                    for (int j = 0; j < 32; j += 4) { const f32x4 a4 = *(const f32x4*)(Ar + i * 260 + c0 + j); accp[i] += (a4[0] * bv[j] + a4[1] * bv[j + 1]) + (a4[2] * bv[j + 2] + a4[3] * bv[j + 3]); }
            }
            u32x4 o; o.x = cvt_pk_bf16(accp[0], accp[1]); o.y = cvt_pk_bf16(accp[2], accp[3]); o.z = cvt_pk_bf16(accp[4], accp[5]); o.w = cvt_pk_bf16(accp[6], accp[7]);
            *(u32x4*)((bf16_t*)(ws + WS_W1T) + (size_t)(2 * D + g * 256 + n0 + nn) * D + k0 + kh * 8) = o;
            asm volatile("s_waitcnt lgkmcnt(0)" ::: "memory");
        }
    }
    { const float* wsp = a.in[8]; bf16_t* o = (bf16_t*)(ws + WS_WSP);
      for (int i = blockIdx.x * 512 + tid; i < 8 * 128 * 128 / 2; i += G * 512) { const int e = 2 * i, p = (e >> 7) & 127, q = e & 127; const bool ok = (q >> 6) <= (p >> 6);
          const f32x2 v = *(const f32x2*)(wsp + e); ((unsigned*)o)[i] = ok ? cvt_pk_bf16(v.x, v.y) : 0u; } }
    if (tid < 64) { unsigned sp = 0;
        while ((unsigned)__builtin_amdgcn_readfirstlane(__hip_atomic_load(modctr, __ATOMIC_RELAXED, __HIP_MEMORY_SCOPE_AGENT)) < (unsigned)(NADA / 24)) { __builtin_amdgcn_s_sleep(2); if (++sp > (1u << 22)) break; }
        __builtin_amdgcn_fence(__ATOMIC_ACQUIRE, "agent");
        asm volatile("s_waitcnt vmcnt(0)" ::: "memory"); }
    __syncthreads();
    const float* x = a.in[0]; const float* g1 = a.in[4]; bf16_t* H = (bf16_t*)(ws + WS_H);
    for (int rg = gw; rg < M / 8; rg += NGW) {
        const int r0 = rg * 8, b = r0 >> 12;
        f32x4 scl[4], sft[4];
#pragma unroll
        for (int j = 0; j < 4; ++j) { const int c = 4 * lane + 256 * j; scl[j] = *(const f32x4*)(g1 + c) * (*(const f32x4*)(mod + b * NADA + D + c) + 1.0f); sft[j] = *(const f32x4*)(mod + b * NADA + c); }
#pragma unroll 2
        for (int r = 0; r < 8; ++r) {
            const float* xr = x + (size_t)(r0 + r) * D + 4 * lane; f32x4 v[4]; float ss = 0.f;
#pragma unroll
            for (int j = 0; j < 4; ++j) { v[j] = __builtin_nontemporal_load((const f32x4*)(xr + 256 * j)); ss += (v[j][0] * v[j][0] + v[j][1] * v[j][1]) + (v[j][2] * v[j][2] + v[j][3] * v[j][3]); }
            const float rstd = __builtin_amdgcn_rsqf(wave_sum(ss) * (1.0f / D) + EPS);
            bf16_t* hr = H + (size_t)(r0 + r) * D + 4 * lane;
#pragma unroll
            for (int j = 0; j < 4; ++j) { const f32x4 o = v[j] * rstd * scl[j] + sft[j]; u32x2 w; w.x = cvt_pk_bf16(o[0], o[1]); w.y = cvt_pk_bf16(o[2], o[3]); *(u32x2*)(hr + 256 * j) = w; }
        }
    }
}

__device__ __forceinline__ void phase1(const Args& a, unsigned char* smem) {
    const int tid = tid_opaque(), lane = tid & 63, wave = tid >> 6, G = gridDim.x;
    unsigned char* ws = a.ws; const float* mod = (const float*)(ws + WS_MOD);
    const float* x = a.in[0]; const float* g1 = a.in[4]; bf16_t* H = (bf16_t*)(ws + WS_H);
    const int gw = blockIdx.x * 8 + wave, NGW = G * 8;
    float* sh2 = (float*)smem;
    for (int i = tid; i < 4 * D; i += 512) sh2[i] = mod[(i >> 10) * NADA + 3 * D + (i & 1023)];
    __syncthreads();
    const bf16_t* Wup = (const bf16_t*)(ws + WS_WUP); const float* convw = a.in[20]; const float* convb = a.in[21];
    float* cb = (float*)(ws + WS_CB); float* cw = (float*)(ws + WS_CW);
    for (int np = gw; np < NUP; np += NGW) {
        float d0 = 0.f, d1 = 0.f, d2 = 0.f, d3 = 0.f;
#pragma unroll
        for (int j = 0; j < 2; ++j) { const int k0 = 8 * lane + 512 * j; const u32x4 w = *(const u32x4*)(Wup + (size_t)np * D + k0);
#pragma unroll
            for (int e = 0; e < 4; ++e) { const float lo = bf_lo(w[e]), hi = bf_hi(w[e]); const int k = k0 + 2 * e;
                d0 += lo * sh2[k] + hi * sh2[k + 1]; d1 += lo * sh2[D + k] + hi * sh2[D + k + 1]; d2 += lo * sh2[2 * D + k] + hi * sh2[2 * D + k + 1]; d3 += lo * sh2[3 * D + k] + hi * sh2[3 * D + k + 1]; } }
        d0 = wave_sum(d0); d1 = wave_sum(d1); d2 = wave_sum(d2); d3 = wave_sum(d3);
        const int pn = np >> 8, r = np & 255, half = r >> 7, jl = r & 127, n = half * DFF + pn * 128 + jl;
        const float w0 = convw[n], w1 = convw[NUP + n], w2 = convw[2 * NUP + n], cbv = convb[n];
        if (lane < 12) { const int sidx = lane >> 2, b = lane & 3; const float sw = sidx == 0 ? w2 : (sidx == 1 ? w1 + w2 : w0 + w1 + w2); const float dv = b == 0 ? d0 : (b == 1 ? d1 : (b == 2 ? d2 : d3));
            cb[(size_t)(sidx * 4 + b) * NUP + np] = cbv + dv * sw; }
        else if (lane < 15) { const int k = lane - 12; cw[k * NUP + np] = k == 0 ? w0 : (k == 1 ? w1 : w2); }
    }
}

__device__ __forceinline__ void phase3(const Args& a, unsigned char* smem) {
    const int G = gridDim.x;
    unsigned char* ws = a.ws;
    bf16_t* U = (bf16_t*)(ws + WS_U); const bf16_t* V = (const bf16_t*)(ws + WS_V); const bf16_t* ZB = (const bf16_t*)(ws + WS_ZB); bf16_t* YB = (bf16_t*)(ws + WS_H);
    const float* vst = (const float*)(ws + WS_VST);
    const bf16_t* Wsp = (const bf16_t*)(ws + WS_WSP);
    const float* lng = a.in[6]; const float* lnb = a.in[7]; const float* bsp = a.in[9]; const float* bpool = a.in[11]; const float* pscale = a.in[12];
#ifndef REP_POOL
#define REP_POOL 1
#endif
#ifndef REP_SPAT
#define REP_SPAT 1
#endif
    for (int it0 = blockIdx.x; it0 < REP_POOL * 512 + REP_SPAT * 1024; it0 += G) {
        int it = it0 < REP_POOL * 512 ? (it0 & 511) : it0 - (REP_POOL - 1) * 512; bool do_store = true;
        if (it >= 512 + 1024) { it -= 1024; do_store = (a.use_cg == 77); }
        __syncthreads();
        const int tid = tid_opaque(), lane = tid & 63, wave = tid >> 6, wr = wave >> 2, wc = wave & 3, fr = lane & 15, fq = lane >> 4;
        if (it < 512) {
            const int tb = it >> 2, g = it & 3, m0 = tb * 128, c0 = g * 256, w = 2 << g, sqm0 = m0 & (SEQ - 1);
            bf16_t* Raw = (bf16_t*)smem;
            {   u32x4 zr[9];
#pragma unroll
                for (int j = 0; j < 9; ++j) { const int idx = tid + 512 * j, r = idx >> 5, cc = idx & 31;
                    zr[j] = (u32x4){0u, 0u, 0u, 0u};
                    if (r >= 16 || sqm0 != 0) zr[j] = *(const u32x4*)(ZB + (size_t)(m0 - 16 + r) * D + c0 + cc * 8); }
#pragma unroll
                for (int j = 0; j < 9; ++j) { const int idx = tid + 512 * j, r = idx >> 5, cc = idx & 31; *(u32x4*)(Raw + r * 264 + cc * 8) = zr[j]; }
            }
            const int cc = tid & 31, strip = tid >> 5, lr0 = strip * 8;
            const f32x4 bp0 = *(const f32x4*)(bpool + c0 + cc * 8), bp1 = *(const f32x4*)(bpool + c0 + cc * 8 + 4), ps0 = *(const f32x4*)(pscale + c0 + cc * 8), ps1 = *(const f32x4*)(pscale + c0 + cc * 8 + 4);
            __syncthreads();
            { const bf16_t* rp = Raw + (lr0 + 16) * 264 + cc * 8;
              float sum[8];
#pragma unroll
              for (int e = 0; e < 8; ++e) sum[e] = 0.f;
              for (int j = 1; j < w; ++j) { const u32x4 z = *(const u32x4*)(rp - j * 264);
#pragma unroll
                  for (int e = 0; e < 4; ++e) { sum[2 * e] += bf_lo(z[e]); sum[2 * e + 1] += bf_hi(z[e]); } }
#pragma unroll
              for (int i = 0; i < 8; ++i) {
                  const u32x4 z = *(const u32x4*)(rp + i * 264); const int sq = sqm0 + lr0 + i; const float inv = 1.0f / (float)(sq + 1 < w ? sq + 1 : w);
                  float o[8];
#pragma unroll
                  for (int e = 0; e < 4; ++e) { const float lo = bf_lo(z[e]), hi = bf_hi(z[e]); sum[2 * e] += lo; sum[2 * e + 1] += hi; o[2 * e] = sum[2 * e] * inv - lo; o[2 * e + 1] = sum[2 * e + 1] * inv - hi; }
#pragma unroll
                  for (int e = 0; e < 8; ++e) o[e] = (o[e] + (e < 4 ? bp0[e & 3] : bp1[e & 3])) * (e < 4 ? ps0[e & 3] : ps1[e & 3]);
                  u32x4 pw; pw.x = cvt_pk_bf16(o[0], o[1]); pw.y = cvt_pk_bf16(o[2], o[3]); pw.z = cvt_pk_bf16(o[4], o[5]); pw.w = cvt_pk_bf16(o[6], o[7]);
                  *(u32x4*)(YB + (size_t)(m0 + lr0 + i) * D + c0 + cc * 8) = pw;
                  const u32x4 zo = *(const u32x4*)(rp + (i - (w - 1)) * 264);
#pragma unroll
                  for (int e = 0; e < 4; ++e) { sum[2 * e] -= bf_lo(zo[e]); sum[2 * e + 1] -= bf_hi(zo[e]); }
              } }
        } else {
            const int si = it - 512, nb = si >> 3, g = si & 7, m0 = nb * 128, c0 = g * 128;
            bf16_t* vT = (bf16_t*)smem;
            float* st = (float*)(smem + 36864);
            const int kmax = wr == 0 ? 2 : 4;
            const bf16_t* Ap = Wsp + (size_t)g * 16384 + (size_t)(64 * wr + fr) * 128 + 8 * fq;
            bf16x8 Af[4][4];
#pragma unroll
            for (int ks = 0; ks < 4; ++ks)
#pragma unroll
                for (int m = 0; m < 4; ++m) Af[ks][m] = (ks < kmax) ? *(const bf16x8*)(Ap + m * 16 * 128 + ks * 32) : (bf16x8){0, 0, 0, 0, 0, 0, 0, 0};
            const int d0 = (tid & 15) * 8;
            u32x4 zv[4];
#pragma unroll
            for (int j = 0; j < 4; ++j) zv[j] = *(const u32x4*)(V + (size_t)(m0 + ((tid + 512 * j) >> 4)) * D + c0 + d0);
            u32x4 uu[4];
#pragma unroll
            for (int m = 0; m < 4; ++m) uu[m] = *(const u32x4*)(U + (size_t)(m0 + 64 * wr + 16 * m + fr) * D + c0 + 32 * wc + 8 * fq);
            const f32x4 ga = *(const f32x4*)(lng + c0 + d0), gb2 = *(const f32x4*)(lng + c0 + d0 + 4), ba = *(const f32x4*)(lnb + c0 + d0), bb = *(const f32x4*)(lnb + c0 + d0 + 4);
            if (tid < 128) { const f32x4* p = (const f32x4*)(vst + (size_t)(m0 + tid) * 32); float sm = 0.f, q = 0.f;
#pragma unroll
                for (int j = 0; j < 8; ++j) { const f32x4 t = p[j]; sm += t[0] + t[2]; q += t[1] + t[3]; }
                const float mu = sm * (1.0f / D), var = q * (1.0f / D) - mu * mu; st[2 * tid] = mu; st[2 * tid + 1] = __builtin_amdgcn_rsqf(var + EPS); }
            __syncthreads();
#pragma unroll
            for (int j = 0; j < 4; ++j) { const int q = (tid + 512 * j) >> 4;
                const u32x4 z = zv[j]; const float mu = st[2 * q], rs = st[2 * q + 1];
                float o[8];
#pragma unroll
                for (int e = 0; e < 4; ++e) { o[2 * e] = bf_lo(z[e]); o[2 * e + 1] = bf_hi(z[e]); }
#pragma unroll
                for (int e = 0; e < 8; ++e) { const float gg = e < 4 ? ga[e & 3] : gb2[e & 3], bbv = e < 4 ? ba[e & 3] : bb[e & 3]; const float y = (o[e] - mu) * rs * gg + bbv;
                    const int d = d0 + e, sw = ((d >> 3) ^ d) & 15;
                    vT[d * 128 + ((((q >> 3) ^ sw) << 3) | (q & 7))] = (bf16_t)(cvt_pk_bf16(y, 0.f) & 0xffffu); } }
            __syncthreads();
            f32x4 acc[4][2];
#pragma unroll
            for (int m = 0; m < 4; ++m)
#pragma unroll
                for (int n = 0; n < 2; ++n) acc[m][n] = (f32x4){0.f, 0.f, 0.f, 0.f};
#pragma unroll
            for (int ks = 0; ks < 4; ++ks) {
                if (ks < kmax) {
                    bf16x8 Bf[2];
#pragma unroll
                    for (int n = 0; n < 2; ++n) { const int d = 32 * wc + 8 * (fr >> 2) + 4 * n + (fr & 3), sw = ((d >> 3) ^ d) & 15; Bf[n] = *(const bf16x8*)(vT + d * 128 + (((ks * 4 + fq) ^ sw) << 3)); }
#pragma unroll
                    for (int m = 0; m < 4; ++m)
#pragma unroll
                        for (int n = 0; n < 2; ++n) acc[m][n] = __builtin_amdgcn_mfma_f32_16x16x32_bf16(Bf[n], Af[ks][m], acc[m][n], 0, 0, 0);
                }
            }
#pragma unroll
            for (int m = 0; m < 4; ++m) { const int p = 64 * wr + 16 * m + fr; const float bs = bsp[g * 128 + p];
                { bf16_t* up = U + (size_t)(m0 + p) * D + c0 + 32 * wc + 8 * fq; const u32x4 uv = uu[m];
                    u32x4 o;
                    o.x = cvt_pk_bf16(bf_lo(uv.x) * (acc[m][0][0] + bs), bf_hi(uv.x) * (acc[m][0][1] + bs)); o.y = cvt_pk_bf16(bf_lo(uv.y) * (acc[m][0][2] + bs), bf_hi(uv.y) * (acc[m][0][3] + bs));
                    o.z = cvt_pk_bf16(bf_lo(uv.z) * (acc[m][1][0] + bs), bf_hi(uv.z) * (acc[m][1][1] + bs)); o.w = cvt_pk_bf16(bf_lo(uv.w) * (acc[m][1][2] + bs), bf_hi(uv.w) * (acc[m][1][3] + bs));
                    if (do_store) *(u32x4*)up = o; } }
        }
    }
}

__device__ __forceinline__ void phase9(const Args& a) {
    const int tid = tid_opaque(), lane = tid & 63, wave = tid >> 6, G = gridDim.x;
    const float* ss3 = (const float*)(a.ws + WS_SS3); const float* gf = a.in[23]; float* out = a.out;
    const int gw = blockIdx.x * 8 + wave, NGW = G * 8;
    f32x4 gv[4];
#pragma unroll
    for (int j = 0; j < 4; ++j) gv[j] = *(const f32x4*)(gf + 4 * lane + 256 * j);
    for (int row0 = gw * 4; row0 < M; row0 += NGW * 4) {
        f32x4 v[4][4]; float rstd[4];
#pragma unroll
        for (int r = 0; r < 4; ++r) {
            const f32x4* p = (const f32x4*)(ss3 + (size_t)(row0 + r) * 16); const f32x4 st = (p[0] + p[1]) + (p[2] + p[3]);
            rstd[r] = __builtin_amdgcn_rsqf(((st[0] + st[1]) + (st[2] + st[3])) * (1.0f / D) + EPS);
            const float* xr = out + (size_t)(row0 + r) * D + 4 * lane;
#pragma unroll
            for (int j = 0; j < 4; ++j) v[r][j] = *(const f32x4*)(xr + 256 * j);
        }
#pragma unroll
        for (int r = 0; r < 4; ++r) { float* xr = out + (size_t)(row0 + r) * D + 4 * lane;
#pragma unroll
            for (int j = 0; j < 4; ++j) *(f32x4*)(xr + 256 * j) = v[r][j] * rstd[r] * gv[j]; }
    }
}

__global__ void __launch_bounds__(512, 2) fwd_megakernel(Args a) {
    extern __shared__ __attribute__((aligned(16))) unsigned char smem[];
    cg::grid_group grid = cg::this_grid();
    LAS unsigned char* lds = (LAS unsigned char*)smem;
    unsigned char* ws = a.ws;
    const int G = gridDim.x, bx = blockIdx.x;

#ifndef PH_MASK
#define PH_MASK 0xFFFF
#endif
#ifndef REP_P0
#define REP_P0 1
#endif
#ifndef REP_P1
#define REP_P1 1
#endif
#ifndef REP_G1
#define REP_G1 1
#endif
#ifndef REP_G2
#define REP_G2 1
#endif
#ifndef REP_G3
#define REP_G3 1
#endif
#ifndef REP_G4
#define REP_G4 1
#endif
#ifndef REP_SYNC
#define REP_SYNC 1
#endif
#define GSYNC() do { for (int _r = 0; _r < REP_SYNC; ++_r) { if (a.use_cg) grid.sync(); else xcd_barrier(xbar); } } while (0)
    volatile LAS unsigned* xst = (volatile LAS unsigned*)(lds + LDS_BYTES - 64);
    if (threadIdx.x < 2) xst[threadIdx.x] = 0u;
    __syncthreads();
    const XcdBarrier xbar = xcd_barrier_post((unsigned*)(ws + WS_CTL), xst);
    for (int rep = 0; rep < REP_P0; ++rep) { phase0(a, smem); __syncthreads(); }
    GSYNC();
    for (int rep = 0; rep < REP_G1; ++rep) {
        pg8::Gemm g; g.A0 = g.A1 = (const bf16_t*)(ws + WS_H); g.B0 = g.B1 = (const bf16_t*)(ws + WS_W1T); g.K = D; g.mstride = 256;
        pg8::TileOrder S; S.init(M / 256, N1 / 256, G, bx, 0);
        Epi1 E{(bf16_t*)(ws + WS_U), (bf16_t*)(ws + WS_V), (bf16_t*)(ws + WS_ZB), (bf16_t*)(ws + WS_G), a.in[16], (float*)(ws + WS_VST)};
        pg8::gemm_phase(lds, g, S, E);
    }
    GSYNC();
    phase1(a, smem); __syncthreads();
    phase3(a, smem);
    GSYNC();
    for (int rep = 0; rep < REP_G2; ++rep) {
        pg8::Gemm g; g.A0 = (const bf16_t*)(ws + WS_U); g.A1 = (const bf16_t*)(ws + WS_H); g.B0 = (const bf16_t*)(ws + WS_WPA); g.B1 = (const bf16_t*)(ws + WS_WPB); g.K = D; g.mstride = 256;
        pg8::TileOrder S; S.init(M / 256, D / 256, G, bx, 1);
        Epi2 E{(const bf16_t*)(ws + WS_G), (bf16_t*)(ws + WS_V)};
        pg8::gemm_phase(lds, g, S, E);
    }
    GSYNC();
    for (int rep = 0; rep < REP_G3; ++rep) {
        pg8::Gemm g; g.A0 = g.A1 = (const bf16_t*)(ws + WS_V); g.B0 = g.B1 = (const bf16_t*)(ws + WS_WOUT); g.K = D; g.mstride = 256;
        pg8::TileOrder S; S.init(M / 256, D / 256, G, bx, 0);
        EpiRes<true> E{a.in[0], a.out, (bf16_t*)(ws + WS_H), (const float*)(ws + WS_MOD), 2 * D, a.in[18], (float*)(ws + WS_SS2), G == (M / 256) * (D / 256) ? (bf16_t*)(ws + WS_G) : nullptr};
        pg8::gemm_phase(lds, g, S, E);
    }
    GSYNC();
    for (int rep = 0; rep < REP_G4; ++rep) {
        pg8::Gemm g; g.A0 = g.A1 = (const bf16_t*)(ws + WS_H) - (size_t)2 * D; g.B0 = g.B1 = (const bf16_t*)(ws + WS_WUP); g.K = D; g.mstride = MT4;
        pg8::TileOrder S; S.init(NM4, NUP / 256, G, bx, 0);
        int pre = 0;
        { Unit pu; if (!S.next(6, pu)) {
              const int t = tid_opaque(); LAS float* rsBig = (LAS float*)(lds + LDS_HALO + 8192);
              if (t < 256) {
#pragma unroll
                  for (int i = 0; i < 6; ++i) if (S.next(i, pu)) { int gr = pu.pm * MT4 - 2 + t; gr = gr < 0 ? 0 : (gr > M - 1 ? M - 1 : gr);
                      const f32x4* p = (const f32x4*)((const float*)(ws + WS_SS2) + (size_t)gr * 16); const f32x4 st = (p[0] + p[1]) + (p[2] + p[3]);
                      rsBig[i * 256 + t] = __builtin_amdgcn_rsqf(((st[0] + st[1]) + (st[2] + st[3])) * (1.0f / D) + EPS); } }
              pre = 6; __syncthreads(); } }
        Epi4 E{(const float*)(ws + WS_SS2), (const float*)(ws + WS_CB), (const float*)(ws + WS_CW), (bf16_t*)(ws + WS_F), pre};
        pg8::gemm_phase(lds, g, S, E);
    }
    GSYNC();
    if (G == (M / 256) * (D / 256)) {
        pg8::Gemm g; g.A0 = g.A1 = (const bf16_t*)(ws + WS_F); g.B0 = g.B1 = (const bf16_t*)(ws + WS_WDN); g.K = DFF; g.mstride = 256;
        pg8::TileOrder S; S.init(M / 256, D / 256, G, bx, 0);
        EpiTail E{a.out, (const float*)(ws + WS_MOD), a.in[23], (float*)(ws + WS_VST), (unsigned*)(ws + WS_CTL + 16384), (const bf16_t*)(ws + WS_G)};
        pg8::gemm_phase(lds, g, S, E);
        return;
    }
    {
        pg8::Gemm g; g.A0 = g.A1 = (const bf16_t*)(ws + WS_F); g.B0 = g.B1 = (const bf16_t*)(ws + WS_WDN); g.K = DFF; g.mstride = 256;
        pg8::TileOrder S; S.init(M / 256, D / 256, G, bx, 0);
        EpiRes<false> E{a.out, a.out, nullptr, (const float*)(ws + WS_MOD), 5 * D, nullptr, (float*)(ws + WS_SS3), nullptr};
        pg8::gemm_phase(lds, g, S, E);
    }
    GSYNC();
    phase9(a);
}

extern "C" void kernel_launch(void* const* d_in, const int* in_sizes, int n_in, void* d_out, int out_size, void* d_ws, size_t ws_size, hipStream_t stream) {
    static int grid = 0;
    if (grid == 0) {
        int dev = 0, cus = 0, per_cu = 0;
        hipGetDevice(&dev);
        hipDeviceGetAttribute(&cus, hipDeviceAttributeMultiprocessorCount, dev);
        hipFuncSetAttribute((const void*)fwd_megakernel, hipFuncAttributeMaxDynamicSharedMemorySize, LDS_BYTES);
        hipOccupancyMaxActiveBlocksPerMultiprocessor(&per_cu, (const void*)fwd_megakernel, 512, LDS_BYTES);
        if (per_cu < 1) { fprintf(stderr, "kernel_launch: occupancy query says %d blocks per CU\n", per_cu); per_cu = 1; }
        grid = cus * per_cu;
    }
    if (hipMemsetAsync((char*)d_ws + WS_CTL, 0, CTL_BYTES, stream) != hipSuccess) fprintf(stderr, "kernel_launch: memset of the barrier words failed\n");
    Args a{};
    for (int i = 0; i < 24; ++i) a.in[i] = (const float*)d_in[i];
    a.out = (float*)d_out; a.ws = (unsigned char*)d_ws;
    void* args[] = {&a};
    hipError_t e = hipLaunchCooperativeKernel((const void*)fwd_megakernel, dim3(grid), dim3(512), args, LDS_BYTES, stream);
    if (e != hipSuccess) fprintf(stderr, "cooperative launch failed: %s (grid %d)\n", hipGetErrorString(e), grid);
}
```

```cpp
#include <hip/hip_runtime.h>
#include <hip/hip_cooperative_groups.h>
#include <cstdio>
#include <cstdint>
namespace cg = cooperative_groups;

#define LAS __attribute__((address_space(3)))
typedef unsigned short bf16_t;
typedef short bf16x8 __attribute__((ext_vector_type(8)));
typedef float f32x4 __attribute__((ext_vector_type(4)));
typedef float f32x2 __attribute__((ext_vector_type(2)));
typedef unsigned u32x4 __attribute__((ext_vector_type(4)));
typedef unsigned u32x2 __attribute__((ext_vector_type(2)));

constexpr int D = 1024, BATCH = 4, SEQ = 4096, M = BATCH * SEQ, DFF = 2816, NUP = 2 * DFF, NADA = 6 * D;
constexpr int N1 = 3 * D + 2 * D;
constexpr float EPS = 1e-6f;
constexpr int MT4 = 254, NM4 = 65;

constexpr size_t MiB = 1u << 20;
constexpr size_t WS_MOD = 0;
constexpr size_t WS_CB = 128 * 1024;
constexpr size_t WS_CW = 512 * 1024;
constexpr size_t WS_VST = 1 * MiB;
constexpr size_t WS_SS2 = 3 * MiB;
constexpr size_t WS_SS3 = 4 * MiB;
constexpr size_t WS_WSP = 5 * MiB;
constexpr size_t WS_WPOOL = 5 * MiB + 512 * 1024;
constexpr size_t WS_W1T = 6 * MiB;
constexpr size_t WS_WPA = 16 * MiB, WS_WPB = 18 * MiB, WS_WOUT = 20 * MiB;
constexpr size_t WS_WUP = 22 * MiB;
constexpr size_t WS_WDN = 33 * MiB;
constexpr size_t WS_H = 40 * MiB;
constexpr size_t WS_U = 72 * MiB;
constexpr size_t WS_V = 104 * MiB;
constexpr size_t WS_ZB = 136 * MiB;
constexpr size_t WS_G = 168 * MiB;
constexpr size_t WS_CTL = 240 * MiB, CTL_BYTES = 64 * 1024;
constexpr size_t WS_F = 72 * MiB;

constexpr int LDS_HALO = 131072;
constexpr int LDS_BYTES = 147456;

__device__ __forceinline__ unsigned cvt_pk_bf16(float lo, float hi) { unsigned r; asm("v_cvt_pk_bf16_f32 %0, %1, %2" : "=v"(r) : "v"(lo), "v"(hi)); return r; }
__device__ __forceinline__ float bf_lo(unsigned w) { return __uint_as_float(w << 16); }
__device__ __forceinline__ float bf_hi(unsigned w) { return __uint_as_float(w & 0xffff0000u); }
__device__ __forceinline__ float wave_sum(float v) {
#pragma unroll
    for (int o = 1; o < 64; o <<= 1) v += __shfl_xor(v, o);
    return v;
}
__device__ __forceinline__ int tid_opaque() { int t = threadIdx.x; asm volatile("" : "+v"(t)); return t; }
__device__ __forceinline__ float sigmoid_f(float x) { return __builtin_amdgcn_rcpf(1.0f + __builtin_amdgcn_exp2f(-1.4426950408889634f * x)); }
__device__ __forceinline__ f32x2 gelu_pk(f32x2 v) {
    const f32x2 av = __builtin_elementwise_abs(v), d = av * 0.2316418882f + 1.0f;
    f32x2 t; t.x = __builtin_amdgcn_rcpf(d.x); t.y = __builtin_amdgcn_rcpf(d.y);
    f32x2 q = t * 0.5307027145f + (-0.7265760135f); q = q * t + 0.7107068705f; q = q * t + (-0.142248368f); q = q * t + 0.127414796f; q = q * t;
    const f32x2 s = (v * v) * (-0.72134752044f);
    f32x2 e; e.x = __builtin_amdgcn_exp2f(s.x); e.y = __builtin_amdgcn_exp2f(s.y);
    const f32x2 m = v * (q * e), r = v - m;
    f32x2 o; o.x = v.x < 0.f ? m.x : r.x; o.y = v.y < 0.f ? m.y : r.y; return o;
}
__device__ __forceinline__ f32x4 gelu4(f32x4 v) { f32x2 a = gelu_pk((f32x2){v[0], v[1]}), b = gelu_pk((f32x2){v[2], v[3]}); return (f32x4){a.x, a.y, b.x, b.y}; }

namespace pg8 {
constexpr int BM = 256, BK = 64, HALF = 128, HTB = HALF * BK * 2, STAGE_BYTES = 8 * HTB, NXCD = 8, WGM = 2;
__host__ __device__ __forceinline__ int lds_byte(int r, int c) { const int st = (r >> 4) * 2 + (c >> 5), rr = r & 15, cc = c & 31, ob = rr * 64 + cc * 2; return st * 1024 + (ob ^ (((ob >> 9) & 1) << 5)); }
__host__ __device__ __forceinline__ void stage_rc(int b, int& R, int& C) { const int st = b / 1024, sb = b % 1024, swz = sb ^ (((sb >> 9) & 1) << 5); R = (st >> 1) * 16 + swz / 64; C = (st & 1) * 32 + (swz % 64) / 2; }
__host__ __device__ __forceinline__ int perm32(int rho) { const int n = rho >> 4, i = rho & 15; return 8 * (i >> 2) + 4 * n + (i & 3); }

struct Unit { int pm, pn, z, ord; };
struct Gemm { const bf16_t* A0; const bf16_t* A1; const bf16_t* B0; const bf16_t* B1; int K; int mstride; };

struct TileOrder {
    int nM, nN, nwg, G, c, ZS;
    __device__ void init(int nM_, int nN_, int G_, int c_, int ZS_) { nM = nM_; nN = nN_; nwg = nM * nN; G = G_; c = c_; ZS = ZS_; }
    __device__ bool next(int i, Unit& u) const {
        const int ti = i >> ZS; u.z = i & ((1 << ZS) - 1); u.ord = i;
        const long L = (long)ti * G + c; if (L >= nwg) return false;
        int wgid = (int)L; { const int q = nwg / NXCD, r = nwg % NXCD, xcd = wgid % NXCD, off = wgid / NXCD; wgid = (xcd < r ? xcd * (q + 1) : r * (q + 1) + (xcd - r) * q) + off; }
        const int nig = WGM * nN, gid = wgid / nig, fm = gid * WGM, gsz = (nM - fm) < WGM ? (nM - fm) : WGM;
        u.pm = fm + ((wgid % nig) % gsz); u.pn = (wgid % nig) / gsz; return true;
    }
};

template <class Epi, class Sched>
__device__ __forceinline__ void gemm_phase(LAS unsigned char* lds, const Gemm g, const Sched& S, const Epi& E) {
    const int tid = tid_opaque(), wid = __builtin_amdgcn_readfirstlane(tid >> 6), lane = tid & 63, wr = wid >> 2, wc = wid & 3, fr = lane & 15, fq = lane >> 4;
    const int K = g.K, nt = K / BK;
    unsigned voffA[2], voffB[2];
#pragma unroll
    for (int i = 0; i < 2; ++i) { int R, C; stage_rc(tid * 16 + i * 8192, R, C); const int Rb = Epi::PERM ? ((R & ~31) + perm32(R & 31)) : R;
        const int Ra = Epi::APERM ? ((R & ~63) + 4 * (R & 15) + ((R & 63) >> 4)) : R;
        voffA[i] = (unsigned)(Ra * K + C) * 2u; voffB[i] = (unsigned)(Rb * K + C) * 2u; }
    const size_t kstep = (size_t)(BK * 2);
    const size_t hstep = (size_t)HALF * K * 2;
    const size_t tstepB = 2 * hstep;
    const size_t tstepA = (size_t)g.mstride * K * 2;
    const unsigned ldsw = (unsigned)wid * 1024u;
    const int aoff = lds_byte(wr * 64 + fr, fq * 8), boff = lds_byte(wc * 32 + fr, fq * 8);
#define PG8_SA(b, h) (((b) * 2 + (h)) * HTB)
#define PG8_SB(b, h) ((4 + (b) * 2 + (h)) * HTB)
#define PG8_STAGE(bufoff, gbase, voff) do { _Pragma("unroll") for (int _i = 0; _i < 2; ++_i) \
        __builtin_amdgcn_global_load_lds((const unsigned*)((const char*)(gbase) + (voff)[_i]), (LAS unsigned*)(lds + (bufoff) + ldsw + _i * 8192), 16, 0, 0); } while (0)
#define PG8_LDA(dst, b, h) do { _Pragma("unroll") for (int m = 0; m < 4; ++m) _Pragma("unroll") for (int k = 0; k < 2; ++k) dst[m][k] = *(const LAS bf16x8*)(lds + PG8_SA(b, h) + aoff + m * 2048 + k * 1024); } while (0)
#define PG8_LDB(dst, b, h) do { _Pragma("unroll") for (int n = 0; n < 2; ++n) _Pragma("unroll") for (int k = 0; k < 2; ++k) dst[n][k] = *(const LAS bf16x8*)(lds + PG8_SB(b, h) + boff + n * 2048 + k * 1024); } while (0)
#define PG8_MMA(ai, bj, At, Bt) do { __builtin_amdgcn_s_setprio(1); _Pragma("unroll") for (int m = 0; m < 4; ++m) _Pragma("unroll") for (int n = 0; n < 2; ++n) _Pragma("unroll") for (int k = 0; k < 2; ++k) \
        acc[ai][bj][m][n] = __builtin_amdgcn_mfma_f32_16x16x32_bf16(Bt[n][k], At[m][k], acc[ai][bj][m][n], 0, 0, 0); __builtin_amdgcn_s_setprio(0); } while (0)
#define PG8_WAIT_V(n) asm volatile("s_waitcnt vmcnt(" #n ")" ::: "memory")
#define PG8_WAIT_L(n) asm volatile("s_waitcnt lgkmcnt(" #n ")" ::: "memory")
#define PG8_BAR __builtin_amdgcn_s_barrier()
#define PG8_SCHED __builtin_amdgcn_sched_barrier(0)
    Unit cur, nxt; int ui = 0;
    if (!S.next(0, cur)) return;
    f32x4 acc[2][2][4][2];
#pragma unroll
    for (int a = 0; a < 2; ++a)
#pragma unroll
        for (int b = 0; b < 2; ++b)
#pragma unroll
            for (int m = 0; m < 4; ++m)
#pragma unroll
                for (int n = 0; n < 2; ++n) acc[a][b][m][n] = (f32x4){0.f, 0.f, 0.f, 0.f};
    bf16x8 At[4][2], B0[2][2], B1[2][2];
    const char* cA = (const char*)(cur.z ? g.A1 : g.A0) + (size_t)cur.pm * tstepA; const char* cB = (const char*)(cur.z ? g.B1 : g.B0) + (size_t)cur.pn * tstepB;
    PG8_STAGE(PG8_SB(0, 0), cB, voffB); PG8_STAGE(PG8_SB(0, 1), cB + hstep, voffB); PG8_STAGE(PG8_SA(0, 0), cA, voffA); PG8_STAGE(PG8_SA(0, 1), cA + hstep, voffA);
    if (wr == 1) PG8_BAR;
    PG8_WAIT_V(2); PG8_BAR;
    PG8_STAGE(PG8_SB(1, 0), cB + kstep, voffB); PG8_STAGE(PG8_SA(1, 0), cA + kstep, voffA); PG8_STAGE(PG8_SB(1, 1), cB + hstep + kstep, voffB);
    PG8_WAIT_V(6); PG8_BAR;
    for (;;) {
        const bool has_next = S.next(ui + 1, nxt);
        const char* nA = has_next ? (const char*)(nxt.z ? g.A1 : g.A0) + (size_t)nxt.pm * tstepA : cA; const char* nB = has_next ? (const char*)(nxt.z ? g.B1 : g.B0) + (size_t)nxt.pn * tstepB : cB;
        for (int t = 0; t < nt; t += 2) {
            const bool last = (t == nt - 2);
            const char* a1 = cA + (size_t)(t + 1) * kstep;
            const char* a2 = last ? nA : cA + (size_t)(t + 2) * kstep; const char* b2 = last ? nB : cB + (size_t)(t + 2) * kstep;
            const char* a3 = a2 + kstep; const char* b3 = b2 + kstep;
            PG8_LDB(B0, 0, 0); PG8_LDB(B1, 0, 1); PG8_SCHED; PG8_LDA(At, 0, 0); PG8_STAGE(PG8_SA(1, 1), a1 + hstep, voffA);
            PG8_WAIT_V(8); PG8_WAIT_L(0); PG8_BAR; PG8_MMA(0, 0, At, B0); PG8_MMA(0, 1, At, B1); PG8_BAR; PG8_SCHED;
            PG8_LDA(At, 0, 1); PG8_STAGE(PG8_SB(0, 0), b2, voffB); PG8_STAGE(PG8_SB(0, 1), b2 + hstep, voffB); PG8_STAGE(PG8_SA(0, 0), a2, voffA);
            PG8_WAIT_V(8); PG8_WAIT_L(0); PG8_BAR; PG8_MMA(1, 0, At, B0); PG8_MMA(1, 1, At, B1); PG8_BAR; PG8_SCHED;
            PG8_LDB(B0, 1, 0); PG8_LDB(B1, 1, 1); PG8_SCHED; PG8_LDA(At, 1, 0); PG8_STAGE(PG8_SA(0, 1), a2 + hstep, voffA);
            PG8_WAIT_V(8); PG8_WAIT_L(0); PG8_BAR; PG8_MMA(0, 0, At, B0); PG8_MMA(0, 1, At, B1); PG8_BAR; PG8_SCHED;
            PG8_LDA(At, 1, 1); PG8_STAGE(PG8_SB(1, 0), b3, voffB); PG8_STAGE(PG8_SB(1, 1), b3 + hstep, voffB); PG8_STAGE(PG8_SA(1, 0), a3, voffA);
            PG8_WAIT_V(8); PG8_WAIT_L(0); PG8_BAR; PG8_MMA(1, 0, At, B0); PG8_MMA(1, 1, At, B1); PG8_BAR; PG8_SCHED;
        }
        if (wr == 0) PG8_BAR;
        E(acc, cur, wr, wc, fr, fq, lds);
        if (!has_next) break;
        if (!E.keep(cur)) {
#pragma unroll
        for (int a = 0; a < 2; ++a)
#pragma unroll
            for (int b = 0; b < 2; ++b)
#pragma unroll
                for (int m = 0; m < 4; ++m)
#pragma unroll
                    for (int n = 0; n < 2; ++n) acc[a][b][m][n] = (f32x4){0.f, 0.f, 0.f, 0.f};
        }
        cur = nxt; cA = nA; cB = nB; ++ui;
        if (wr == 1) PG8_BAR;
    }
    PG8_WAIT_V(0);
    PG8_BAR;
#undef PG8_SA
#undef PG8_SB
#undef PG8_STAGE
#undef PG8_LDA
#undef PG8_LDB
#undef PG8_MMA
#undef PG8_WAIT_V
#undef PG8_WAIT_L
#undef PG8_BAR
#undef PG8_SCHED
}
}
using pg8::Unit;

struct Epi1 {
    static constexpr bool PERM = true, APERM = false;
    bf16_t *U, *V, *ZB, *G; const float* bgate; float* vst;
    __device__ __forceinline__ bool keep(const Unit&) const { return false; }
    __device__ __forceinline__ void operator()(f32x4 (&acc)[2][2][4][2], const Unit& u, int wr, int wc, int fr, int fq, LAS unsigned char*) const {
        const int seg = u.pn >> 2;
        const int row0 = u.pm * 256 + wr * 64 + fr;
        bf16_t* base; int ld, colt;
        if (seg == 0) { base = U; ld = D; colt = u.pn * 256; }
        else if (seg == 1) { base = V; ld = D; colt = (u.pn - 4) * 256; }
        else if (seg == 2) { base = ZB; ld = D; colt = (u.pn - 8) * 256; }
        else { base = G; ld = 2 * D; colt = (u.pn - 12) * 256; }
        const int col0 = colt + wc * 32 + 8 * fq;
        f32x4 bv[2][2];
#pragma unroll
        for (int bj = 0; bj < 2; ++bj)
#pragma unroll
            for (int n = 0; n < 2; ++n) bv[bj][n] = (seg >= 3) ? *(const f32x4*)(bgate + col0 + bj * 128 + 4 * n) : (f32x4){0.f, 0.f, 0.f, 0.f};
#pragma unroll
        for (int ai = 0; ai < 2; ++ai)
#pragma unroll
            for (int m = 0; m < 4; ++m) {
                const int row = row0 + ai * 128 + m * 16;
                bf16_t* rowp = base + (size_t)row * ld + col0;
                float s = 0.f, q = 0.f;
#pragma unroll
                for (int bj = 0; bj < 2; ++bj) {
                    f32x4 v0 = acc[ai][bj][m][0] + bv[bj][0], v1 = acc[ai][bj][m][1] + bv[bj][1];
                    if (seg <= 1) { v0 = gelu4(v0); v1 = gelu4(v1); }
                    else if (seg == 3) {
#pragma unroll
                        for (int j = 0; j < 4; ++j) { v0[j] = sigmoid_f(v0[j]); v1[j] = sigmoid_f(v1[j]); }
                    }
                    else if (seg == 4) {
#pragma unroll
                        for (int j = 0; j < 4; ++j) { v0[j] = 1.0f + __builtin_amdgcn_exp2f(-1.4426950408889634f * fmaxf(v0[j], -80.0f)); v1[j] = 1.0f + __builtin_amdgcn_exp2f(-1.4426950408889634f * fmaxf(v1[j], -80.0f)); }
                    }
                    if (seg == 1) {
#pragma unroll
                        for (int j = 0; j < 4; ++j) { s += v0[j] + v1[j]; q += v0[j] * v0[j] + v1[j] * v1[j]; }
                    }
                    u32x4 w; w.x = cvt_pk_bf16(v0[0], v0[1]); w.y = cvt_pk_bf16(v0[2], v0[3]); w.z = cvt_pk_bf16(v1[0], v1[1]); w.w = cvt_pk_bf16(v1[2], v1[3]);
                    *(u32x4*)(rowp + bj * 128) = w;
                }
                if (seg == 1) {
                    s += __shfl_xor(s, 16); s += __shfl_xor(s, 32); q += __shfl_xor(q, 16); q += __shfl_xor(q, 32);
                    if (fq == 0) *(f32x2*)(vst + ((size_t)row * 16 + (u.pn - 4) * 4 + wc) * 2) = (f32x2){s, q};
                }
            }
    }
};
struct Epi2 {
    static constexpr bool PERM = true, APERM = false;
    const bf16_t* G; bf16_t* O;
    __device__ __forceinline__ bool keep(const Unit& u) const { return u.z == 0; }
    __device__ __forceinline__ void operator()(f32x4 (&acc)[2][2][4][2], const Unit& u, int wr, int wc, int fr, int fq, LAS unsigned char*) const {
        const int row0 = u.pm * 256 + wr * 64 + fr, col0 = u.pn * 256 + wc * 32 + 8 * fq;
        if (u.z == 0) {
#pragma unroll
            for (int ai = 0; ai < 2; ++ai)
#pragma unroll
                for (int m = 0; m < 4; ++m) {
                    const bf16_t* gp = G + (size_t)(row0 + ai * 128 + m * 16) * (2 * D) + col0;
#pragma unroll
                    for (int bj = 0; bj < 2; ++bj) {
                        const u32x4 ga4 = *(const u32x4*)(gp + bj * 128), gb4 = *(const u32x4*)(gp + D + bj * 128);
#pragma unroll
                        for (int n = 0; n < 2; ++n) {
                            const unsigned gax = n ? ga4.z : ga4.x, gay = n ? ga4.w : ga4.y, gbx = n ? gb4.z : gb4.x, gby = n ? gb4.w : gb4.y;
                            f32x4 r;
                            r[0] = bf_lo(gax) * bf_lo(gbx); r[1] = bf_hi(gax) * bf_hi(gbx);
                            r[2] = bf_lo(gay) * bf_lo(gby); r[3] = bf_hi(gay) * bf_hi(gby);
                            acc[ai][bj][m][n] *= r;
                        }
                    }
                    if (m & 1) asm volatile("" ::: "memory");
                }
        } else {
#pragma unroll
            for (int ai = 0; ai < 2; ++ai)
#pragma unroll
                for (int m = 0; m < 4; ++m) {
                    const size_t row = (size_t)(row0 + ai * 128 + m * 16);
                    const bf16_t* gp = G + row * (2 * D) + D + col0;
#pragma unroll
                    for (int bj = 0; bj < 2; ++bj) {
                        const u32x4 gb = *(const u32x4*)(gp + bj * 128);
                        const f32x4 a0 = acc[ai][bj][m][0], a1 = acc[ai][bj][m][1];
                        u32x4 w;
                        w.x = cvt_pk_bf16(a0[0] * __builtin_amdgcn_rcpf(bf_lo(gb.x)), a0[1] * __builtin_amdgcn_rcpf(bf_hi(gb.x)));
                        w.y = cvt_pk_bf16(a0[2] * __builtin_amdgcn_rcpf(bf_lo(gb.y)), a0[3] * __builtin_amdgcn_rcpf(bf_hi(gb.y)));
                        w.z = cvt_pk_bf16(a1[0] * __builtin_amdgcn_rcpf(bf_lo(gb.z)), a1[1] * __builtin_amdgcn_rcpf(bf_hi(gb.z)));
                        w.w = cvt_pk_bf16(a1[2] * __builtin_amdgcn_rcpf(bf_lo(gb.w)), a1[3] * __builtin_amdgcn_rcpf(bf_hi(gb.w)));
                        *(u32x4*)(O + row * D + col0 + bj * 128) = w;
                    }
                    asm volatile("" ::: "memory");
                }
        }
    }
};
template <bool WITH_A2> struct EpiRes {
    static constexpr bool PERM = false, APERM = false;
    const float* xi; float* xo; bf16_t* a2; const float* mod; int gate_off; const float* g2; float* ss; bf16_t* x1b;
    __device__ __forceinline__ bool keep(const Unit&) const { return false; }
    __device__ __forceinline__ void operator()(f32x4 (&acc)[2][2][4][2], const Unit& u, int wr, int wc, int fr, int fq, LAS unsigned char*) const {
        const int b = (u.pm * 256) >> 12;
        const int row0 = u.pm * 256 + wr * 64 + fr, col0 = u.pn * 256 + wc * 32 + 4 * fq;
        f32x4 gt[2][2], sc[2][2];
#pragma unroll
        for (int bj = 0; bj < 2; ++bj)
#pragma unroll
            for (int n = 0; n < 2; ++n) {
                const int c = col0 + bj * 128 + n * 16;
                gt[bj][n] = *(const f32x4*)(mod + b * NADA + gate_off + c);
                if (WITH_A2) sc[bj][n] = *(const f32x4*)(g2 + c) * (*(const f32x4*)(mod + b * NADA + 4 * D + c) + 1.0f);
            }
#pragma unroll
        for (int ai = 0; ai < 2; ++ai)
#pragma unroll
            for (int m = 0; m < 4; ++m) {
                const int row = row0 + ai * 128 + m * 16; const size_t off = (size_t)row * D + col0;
                float q = 0.f;
#pragma unroll
                for (int bj = 0; bj < 2; ++bj) {
                    u32x2 wn[2], wx[2];
#pragma unroll
                    for (int n = 0; n < 2; ++n) {
                        const f32x4 xv = *(const f32x4*)(xi + off + bj * 128 + n * 16);
                        const f32x4 v = xv + gt[bj][n] * acc[ai][bj][m][n];
                        if (WITH_A2 && x1b) { wx[n].x = cvt_pk_bf16(v[0], v[1]); wx[n].y = cvt_pk_bf16(v[2], v[3]); }
                        else *(f32x4*)(xo + off + bj * 128 + n * 16) = v;
                        q += (v[0] * v[0] + v[1] * v[1]) + (v[2] * v[2] + v[3] * v[3]);
                        if (WITH_A2) { const f32x4 a = v * sc[bj][n]; wn[n].x = cvt_pk_bf16(a[0], a[1]); wn[n].y = cvt_pk_bf16(a[2], a[3]); }
                    }
                    if (WITH_A2 && x1b) {
                        const auto rx = __builtin_amdgcn_permlane16_swap(wx[0].x, wx[1].x, false, false), ry = __builtin_amdgcn_permlane16_swap(wx[0].y, wx[1].y, false, false);
                        *(u32x4*)(x1b + off + bj * 128 + ((fq & 1) ? 12 : 0)) = (u32x4){rx[0], ry[0], rx[1], ry[1]};
                    }
                    if (WITH_A2) {
                        const auto rx = __builtin_amdgcn_permlane16_swap(wn[0].x, wn[1].x, false, false), ry = __builtin_amdgcn_permlane16_swap(wn[0].y, wn[1].y, false, false);
                        const u32x4 w16 = (u32x4){rx[0], ry[0], rx[1], ry[1]};
                        const int cofs = (fq & 1) ? 16 + 4 * (fq - 1) - 4 * fq : 0;
                        *(u32x4*)(a2 + off + bj * 128 + cofs) = w16;
                    }
                }
                q += __shfl_xor(q, 16); q += __shfl_xor(q, 32);
                if (fq == 0) ss[(size_t)row * 16 + u.pn * 4 + wc] = q;
            }
    }
};
struct EpiTail {
    static constexpr bool PERM = false, APERM = false;
    float* xio; const float* mod; const float* gf; float* xbuf; unsigned* cnt; const bf16_t* x1b;
    __device__ __forceinline__ bool keep(const Unit&) const { return false; }
    __device__ __forceinline__ void operator()(f32x4 (&acc)[2][2][4][2], const Unit& u, int wr, int wc, int fr, int fq, LAS unsigned char* lds) const {
        const int b = (u.pm * 256) >> 12, tidx = tid_opaque();
        const int row0 = u.pm * 256 + wr * 64 + fr, col0 = u.pn * 256 + wc * 32 + 4 * fq;
        LAS float* P = (LAS float*)(lds + LDS_HALO);
        LAS float* S = (LAS float*)(lds + LDS_HALO + 4096);
        {
            f32x4 gt[2][2];
#pragma unroll
            for (int bj = 0; bj < 2; ++bj)
#pragma unroll
                for (int n = 0; n < 2; ++n) gt[bj][n] = *(const f32x4*)(mod + b * NADA + 5 * D + col0 + bj * 128 + n * 16);
#pragma unroll
            for (int ai = 0; ai < 2; ++ai)
#pragma unroll
                for (int m = 0; m < 4; ++m) {
                    const size_t off = (size_t)(row0 + ai * 128 + m * 16) * D + col0;
                    float q = 0.f;
#pragma unroll
                    for (int bj = 0; bj < 2; ++bj) {
                        const u32x4 L = *(const u32x4*)(x1b + off + bj * 128 + ((fq & 1) ? 12 : 0));
                        const auto rx = __builtin_amdgcn_permlane16_swap(L.x, L.z, false, false), ry = __builtin_amdgcn_permlane16_swap(L.y, L.w, false, false);
#pragma unroll
                        for (int n = 0; n < 2; ++n) {
                            const f32x4 xv = (f32x4){bf_lo(rx[n]), bf_hi(rx[n]), bf_lo(ry[n]), bf_hi(ry[n])};
                            const f32x4 v = xv + gt[bj][n] * acc[ai][bj][m][n];
                            acc[ai][bj][m][n] = v;
                            q += (v[0] * v[0] + v[1] * v[1]) + (v[2] * v[2] + v[3] * v[3]);
                        }
                    }
                    q += __shfl_xor(q, 16); q += __shfl_xor(q, 32);
                    if (fq == 0) P[(ai * 128 + wr * 64 + m * 16 + fr) * 4 + wc] = q;
                    asm volatile("" ::: "memory");
                }
        }
        asm volatile("s_waitcnt lgkmcnt(0)" ::: "memory"); __builtin_amdgcn_s_barrier(); asm volatile("" ::: "memory");
        if (tidx < 256) { const f32x4 p = *(const LAS f32x4*)(P + tidx * 4);
            __hip_atomic_store(xbuf + (size_t)(u.pm * 256 + tidx) * 4 + u.pn, (p[0] + p[1]) + (p[2] + p[3]), __ATOMIC_RELAXED, __HIP_MEMORY_SCOPE_AGENT); }
        asm volatile("s_waitcnt vmcnt(0)" ::: "memory"); __builtin_amdgcn_s_barrier(); asm volatile("" ::: "memory");
        if (tidx < 64) {
            if (tidx == 0) __hip_atomic_fetch_add(cnt + 64 * u.pm, 1u, __ATOMIC_RELAXED, __HIP_MEMORY_SCOPE_AGENT);
            unsigned sp = 0;
            while ((unsigned)__builtin_amdgcn_readfirstlane(__hip_atomic_load(cnt + 64 * u.pm, __ATOMIC_RELAXED, __HIP_MEMORY_SCOPE_AGENT)) < 4u) { __builtin_amdgcn_s_sleep(2); if (++sp > (1u << 22)) break; }
            __builtin_amdgcn_fence(__ATOMIC_ACQUIRE, "agent");
            asm volatile("s_waitcnt vmcnt(0)" ::: "memory");
        }
        __builtin_amdgcn_s_barrier(); asm volatile("" ::: "memory");
        if (tidx < 256) { const float* xp = xbuf + (size_t)(u.pm * 256 + tidx) * 4; float t = 0.f;
#pragma unroll
            for (int j = 0; j < 4; ++j) t += __hip_atomic_load(xp + j, __ATOMIC_RELAXED, __HIP_MEMORY_SCOPE_AGENT);
            S[tidx] = __builtin_amdgcn_rsqf(t * (1.0f / D) + EPS); }
        asm volatile("s_waitcnt vmcnt(0) lgkmcnt(0)" ::: "memory"); __builtin_amdgcn_s_barrier(); asm volatile("" ::: "memory");
        f32x4 gv[2][2];
#pragma unroll
        for (int bj = 0; bj < 2; ++bj)
#pragma unroll
            for (int n = 0; n < 2; ++n) gv[bj][n] = *(const f32x4*)(gf + col0 + bj * 128 + n * 16);
#pragma unroll
        for (int ai = 0; ai < 2; ++ai)
#pragma unroll
            for (int m = 0; m < 4; ++m) {
                const float rstd = S[ai * 128 + wr * 64 + m * 16 + fr];
                const size_t off = (size_t)(row0 + ai * 128 + m * 16) * D + col0;
#pragma unroll
                for (int bj = 0; bj < 2; ++bj)
#pragma unroll
                    for (int n = 0; n < 2; ++n) *(f32x4*)(xio + off + bj * 128 + n * 16) = acc[ai][bj][m][n] * rstd * gv[bj][n];
            }
    }
};
template <int CTRL> __device__ __forceinline__ float dpp_old(float old, float v) { return __int_as_float(__builtin_amdgcn_update_dpp(__float_as_int(old), __float_as_int(v), CTRL, 0xf, 0xf, false)); }
template <int CTRL> __device__ __forceinline__ float dpp_ror(float v) { return __int_as_float(__builtin_amdgcn_update_dpp(0, __float_as_int(v), CTRL, 0xf, 0xf, false)); }
struct Epi4 {
    static constexpr bool PERM = true, APERM = true;
    const float* ss2; const float* cb; const float* cw; bf16_t* F; int pre;
    __device__ __forceinline__ bool keep(const Unit&) const { return false; }
    __device__ __forceinline__ void operator()(f32x4 (&acc)[2][2][4][2], const Unit& u, int wr, int wc, int fr, int fq, LAS unsigned char* lds) const {
        const int grow0 = u.pm * MT4 - 2;
        LAS float* hal = (LAS float*)(lds + LDS_HALO);
        LAS float* rsT = (LAS float*)(lds + LDS_HALO + 8192) + (pre ? u.ord * 256 : 0);
        LAS int* infT = (LAS int*)(lds + LDS_HALO + 8192 + 6144);
        const int s0 = grow0 & (SEQ - 1);
        const bool fast = grow0 >= 0 && s0 >= 2 && s0 + 255 < SEQ && grow0 + 255 < M;
        if (pre == 0 || !fast) {
            const int tidx = tid_opaque();
            if (tidx < 256) {
                const int lr = tidx, gr = grow0 + lr, grc = gr < 0 ? 0 : (gr > M - 1 ? M - 1 : gr);
                if (pre == 0) { const f32x4* p = (const f32x4*)(ss2 + (size_t)grc * 16);
                    const f32x4 st = (p[0] + p[1]) + (p[2] + p[3]);
                    rsT[lr] = __builtin_amdgcn_rsqf(((st[0] + st[1]) + (st[2] + st[3])) * (1.0f / D) + EPS); }
                const int sq = grc & (SEQ - 1), b = grc >> 12, sidx = sq < 2 ? sq : 2;
                infT[lr] = (sidx * 4 + b) | (sq >= 1 ? 16 : 0) | (sq >= 2 ? 32 : 0) | ((lr >= 2 && gr < M) ? 64 : 0);
            }
            asm volatile("s_waitcnt lgkmcnt(0)" ::: "memory"); __builtin_amdgcn_s_barrier(); asm volatile("" ::: "memory");
        }
#pragma unroll
        for (int ai = 0; ai < 2; ++ai)
#pragma unroll
            for (int m = 0; m < 4; ++m) {
                const float rstd = rsT[ai * 128 + wr * 64 + 4 * fr + m];
#pragma unroll
                for (int bj = 0; bj < 2; ++bj)
#pragma unroll
                    for (int n = 0; n < 2; ++n) acc[ai][bj][m][n] *= rstd;
            }
        const int ccol = wc * 32 + 8 * fq;
        if (fr == 15) {
#pragma unroll
            for (int ai = 0; ai < 2; ++ai)
#pragma unroll
                for (int bj = 0; bj < 2; ++bj)
#pragma unroll
                    for (int n = 0; n < 2; ++n) {
                        *(LAS f32x4*)(hal + ((ai * 2 + wr) * 2 + 0) * 256 + bj * 128 + ccol + 4 * n) = acc[ai][bj][2][n];
                        *(LAS f32x4*)(hal + ((ai * 2 + wr) * 2 + 1) * 256 + bj * 128 + ccol + 4 * n) = acc[ai][bj][3][n];
                    }
        }
        asm volatile("s_waitcnt lgkmcnt(0)" ::: "memory"); __builtin_amdgcn_s_barrier(); asm volatile("" ::: "memory");
        if (fast) conv<true>(acc, u, wr, wc, fr, fq, hal, infT, grow0);
        else conv<false>(acc, u, wr, wc, fr, fq, hal, infT, grow0);
    }
    template <bool FAST> __device__ __forceinline__ void conv(f32x4 (&acc)[2][2][4][2], const Unit& u, int wr, int wc, int fr, int fq, LAS float* hal, LAS int* infT, int grow0) const {
        const int ccol = wc * 32 + 8 * fq;
        const int ncol0 = u.pn * 256 + ccol;
        const int cidx = 8 + (grow0 >> 12);
        u32x2 pk0[2][4];
#pragma unroll
        for (int n = 0; n < 2; ++n) {
            f32x4 w0[2], w1[2], w2[2], cbc[2];
#pragma unroll
            for (int bj = 0; bj < 2; ++bj) { const int c = ncol0 + bj * 128 + 4 * n; w0[bj] = *(const f32x4*)(cw + c); w1[bj] = *(const f32x4*)(cw + NUP + c); w2[bj] = *(const f32x4*)(cw + 2 * NUP + c);
                if (FAST) cbc[bj] = *(const f32x4*)(cb + (size_t)cidx * NUP + c); }
#pragma unroll
            for (int ai = 0; ai < 2; ++ai) {
                const int grp = ai * 2 + wr;
                f32x4 P3[2], P2[2];
#pragma unroll
                for (int bj = 0; bj < 2; ++bj) {
                    f32x4 c1, c2;
                    if (grp > 0) { c1 = *(const LAS f32x4*)(hal + ((grp - 1) * 2 + 1) * 256 + bj * 128 + ccol + 4 * n); c2 = *(const LAS f32x4*)(hal + ((grp - 1) * 2 + 0) * 256 + bj * 128 + ccol + 4 * n); }
                    else { c1 = (f32x4){0.f, 0.f, 0.f, 0.f}; c2 = (f32x4){0.f, 0.f, 0.f, 0.f}; }
#pragma unroll
                    for (int j = 0; j < 4; ++j) { P3[bj][j] = dpp_old<0x111>(c1[j], acc[ai][bj][3][n][j]); P2[bj][j] = dpp_old<0x111>(c2[j], acc[ai][bj][2][n][j]); }
                }
#pragma unroll
                for (int m = 0; m < 4; ++m) {
                    const int lr = ai * 128 + wr * 64 + 4 * fr + m;
                    int info = 0; if (!FAST) info = infT[lr];
                    f32x4 val[2];
#pragma unroll
                    for (int bj = 0; bj < 2; ++bj) {
                        const f32x4 Xm = acc[ai][bj][m][n];
                        f32x4 S1 = m == 0 ? P3[bj] : acc[ai][bj][m > 0 ? m - 1 : 0][n];
                        f32x4 S2 = m == 0 ? P2[bj] : (m == 1 ? P3[bj] : acc[ai][bj][m > 1 ? m - 2 : 0][n]);
                        f32x4 cbv;
                        if (FAST) cbv = cbc[bj];
                        else { cbv = *(const f32x4*)(cb + (size_t)(info & 15) * NUP + ncol0 + bj * 128 + 4 * n);
#pragma unroll
                            for (int j = 0; j < 4; ++j) { S1[j] = (info & 16) ? S1[j] : 0.f; S2[j] = (info & 32) ? S2[j] : 0.f; } }
                        val[bj] = cbv + w2[bj] * Xm + w1[bj] * S1 + w0[bj] * S2;
                    }
                    f32x4 f;
#pragma unroll
                    for (int j = 0; j < 4; ++j) f[j] = val[0][j] * sigmoid_f(val[0][j]) * val[1][j];
                    u32x2 w; w.x = cvt_pk_bf16(f[0], f[1]); w.y = cvt_pk_bf16(f[2], f[3]);
                    bool st = lr >= 2; if (!FAST) st = (info & 64) != 0;
                    if (n == 0) pk0[ai][m] = w;
                    else if (st) *(u32x4*)(F + (size_t)(grow0 + lr) * DFF + u.pn * 128 + ccol) = (u32x4){pk0[ai][m].x, pk0[ai][m].y, w.x, w.y};
                }
                if (!FAST) asm volatile("" ::: "memory");
            }
        }
    }
};


#define XB_TMO      128
#define XB_XCNT(j)  (256  + 64 * (j))
#define XB_XSUB(j)  (1280 + 64 * (j))
#define XB_XGEN(j)  (2304 + 64 * (j))
#define XB_TOP      3328
#define XB_TOPGEN   3392
#define XCD_BAR_WORDS 3456
#define XB_SPIN_CAP (1u << 22)
__device__ __forceinline__ unsigned xb_ld(unsigned* p)              { return __hip_atomic_load(p, __ATOMIC_RELAXED, __HIP_MEMORY_SCOPE_AGENT); }
__device__ __forceinline__ unsigned xb_add(unsigned* p, unsigned v) { return __hip_atomic_fetch_add(p, v, __ATOMIC_RELAXED, __HIP_MEMORY_SCOPE_AGENT); }
__device__ __forceinline__ unsigned xb_xcc_id() { return (unsigned)__builtin_amdgcn_s_getreg((3 << 11) | 20) & 0xFu; }
#define XB_SPIN(cond, bar) do { unsigned _sp = 0; while (cond) { __builtin_amdgcn_s_sleep(1); \
    if ((++_sp & 255u) == 0u) { if (xb_ld(&(bar)[XB_TMO])) break; if (_sp > XB_SPIN_CAP) { atomicAdd(&(bar)[XB_TMO], 1u); break; } } } } while (0)
struct XcdBarrier { unsigned* bar; unsigned x; volatile LAS unsigned* st; };
__device__ __forceinline__ XcdBarrier xcd_barrier_post(unsigned* bar, volatile LAS unsigned* st) {
    XcdBarrier b; b.bar = bar; b.x = xb_xcc_id(); b.st = st;
    if (threadIdx.x == 0) (void)xb_add(&bar[XB_XCNT(b.x)], 1u);
    return b;
}
__device__ __forceinline__ void xcd_barrier_complete(unsigned* bar, unsigned x, unsigned& nloc, unsigned& nx) {
    const unsigned G = gridDim.x * gridDim.y * gridDim.z;
    unsigned sum, cnt, mine, sp = 0u;
    for (;;) {
        sum = 0u; cnt = 0u; mine = 0u;
#pragma unroll
        for (unsigned j = 0; j < 16; ++j) { const unsigned c = xb_ld(&bar[XB_XCNT(j)]); sum += c; cnt += (c > 0u) ? 1u : 0u; mine = (j == x) ? c : mine; }
        if (sum == G) break;
        __builtin_amdgcn_s_sleep(1);
        if ((++sp & 255u) == 0u) { if (xb_ld(&bar[XB_TMO])) break; if (sp > XB_SPIN_CAP) { atomicAdd(&bar[XB_TMO], 1u); break; } }
    }
    nloc = mine > 0u ? mine : 1u; nx = cnt > 0u ? cnt : 1u;
}
__device__ __forceinline__ void xcd_barrier(const XcdBarrier& b) {
    asm volatile("s_waitcnt vmcnt(0)" ::: "memory");
    __syncthreads();
    if (threadIdx.x == 0) {
        unsigned* bar = b.bar;
        __builtin_amdgcn_s_waitcnt(0);
        unsigned nloc = b.st[0], nx = b.st[1];
        if (nloc == 0u) { xcd_barrier_complete(bar, b.x, nloc, nx); b.st[0] = nloc; b.st[1] = nx; }
        const unsigned old = xb_add(&bar[XB_XSUB(b.x)], 1u);
        const unsigned gen = old / nloc;
        if (old + 1u == (gen + 1u) * nloc) {
            __builtin_amdgcn_fence(__ATOMIC_RELEASE, "agent");
            asm volatile("s_waitcnt vmcnt(0)" ::: "memory");
            const unsigned og = xb_add(&bar[XB_TOP], 1u);
            const unsigned tg = og / nx;
            if (og + 1u == (tg + 1u) * nx) xb_add(&bar[XB_TOPGEN], 1u);
            else XB_SPIN(xb_ld(&bar[XB_TOPGEN]) == tg, bar);
            __builtin_amdgcn_fence(__ATOMIC_ACQUIRE, "agent");
            xb_add(&bar[XB_XGEN(b.x)], 1u);
            asm volatile("s_waitcnt vmcnt(0)" ::: "memory");
        } else {
            XB_SPIN(xb_ld(&bar[XB_XGEN(b.x)]) == gen, bar);
            __builtin_amdgcn_fence(__ATOMIC_ACQUIRE, "agent");
            asm volatile("s_waitcnt vmcnt(0)" ::: "memory");
        }
    }
    __syncthreads();
}


__device__ __forceinline__ void xcd_barrier_arrive(const XcdBarrier& b) {
    asm volatile("s_waitcnt vmcnt(0)" ::: "memory");
    __syncthreads();
    if (threadIdx.x == 0) {
        unsigned* bar = b.bar;
        __builtin_amdgcn_s_waitcnt(0);
        unsigned nloc = b.st[0], nx = b.st[1];
        if (nloc == 0u) { xcd_barrier_complete(bar, b.x, nloc, nx); b.st[0] = nloc; b.st[1] = nx; }
        const unsigned old = xb_add(&bar[XB_XSUB(b.x)], 1u);
        const unsigned gen = old / nloc;
        unsigned role = 0u, tg = 0u;
        if (old + 1u == (gen + 1u) * nloc) {
            __builtin_amdgcn_fence(__ATOMIC_RELEASE, "agent");
            asm volatile("s_waitcnt vmcnt(0)" ::: "memory");
            const unsigned og = xb_add(&bar[XB_TOP], 1u);
            tg = og / nx; role = 1u;
            if (og + 1u == (tg + 1u) * nx) { xb_add(&bar[XB_TOPGEN], 1u); role = 2u; }
        }
        b.st[4] = role; b.st[5] = gen; b.st[6] = tg;
    }
}
__device__ __forceinline__ void xcd_barrier_wait(const XcdBarrier& b) {
    if (threadIdx.x == 0) {
        unsigned* bar = b.bar;
        const unsigned role = b.st[4], gen = b.st[5], tg = b.st[6];
        if (role != 0u) {
            if (role == 1u) XB_SPIN(xb_ld(&bar[XB_TOPGEN]) == tg, bar);
            __builtin_amdgcn_fence(__ATOMIC_ACQUIRE, "agent");
            xb_add(&bar[XB_XGEN(b.x)], 1u);
            asm volatile("s_waitcnt vmcnt(0)" ::: "memory");
        } else {
            XB_SPIN(xb_ld(&bar[XB_XGEN(b.x)]) == gen, bar);
            __builtin_amdgcn_fence(__ATOMIC_ACQUIRE, "agent");
            asm volatile("s_waitcnt vmcnt(0)" ::: "memory");
        }
    }
    __syncthreads();
}

struct Args { const float* in[24]; float* out; unsigned char* ws; int use_cg; int pad; };

__device__ __forceinline__ void transpose_item(const float* W, int K, int N, bf16_t* WT, int dst_row0, int k0, int n0, float* scr, int lane) {
    {   f32x4 v[8];
#pragma unroll
        for (int i = 0; i < 8; ++i) v[i] = __builtin_nontemporal_load((const f32x4*)(W + (size_t)(k0 + 8 * i + (lane >> 3)) * N + n0 + (lane & 7) * 4));
#pragma unroll
        for (int i = 0; i < 8; ++i) { float* d = scr + (8 * i + (lane >> 3)) * 33 + (lane & 7) * 4; d[0] = v[i][0]; d[1] = v[i][1]; d[2] = v[i][2]; d[3] = v[i][3]; }
    }
    asm volatile("s_waitcnt lgkmcnt(0)" ::: "memory");
    const int c = lane & 7;
#pragma unroll
    for (int j = 0; j < 4; ++j) { const int n = (lane >> 3) + 8 * j; const float* s = scr + (8 * c) * 33 + n;
        u32x4 o; o.x = cvt_pk_bf16(s[0 * 33], s[1 * 33]); o.y = cvt_pk_bf16(s[2 * 33], s[3 * 33]); o.z = cvt_pk_bf16(s[4 * 33], s[5 * 33]); o.w = cvt_pk_bf16(s[6 * 33], s[7 * 33]);
        *(u32x4*)(WT + (size_t)(dst_row0 + n) * K + k0 + 8 * c) = o; }
    asm volatile("s_waitcnt lgkmcnt(0)" ::: "memory");
}
__device__ __forceinline__ void phase0(const Args& a, unsigned char* smem) {
    const int tid = tid_opaque(), lane = tid & 63, wave = tid >> 6, G = gridDim.x;
    unsigned char* ws = a.ws;
    float* sc = (float*)(smem + 72 * 1024);
    float* red = (float*)(smem + 88 * 1024);
    const float* c = a.in[1];
    for (int i = tid; i < 4 * D; i += 512) { const float v = c[i]; sc[i] = v * sigmoid_f(v); }
    __syncthreads();
    const float* w_ada = a.in[2]; const float* b_ada = a.in[3]; float* mod = (float*)(ws + WS_MOD);
    unsigned* modctr = (unsigned*)(ws + WS_CTL + 49152);
    for (int nc = blockIdx.x; nc < NADA / 24; nc += G) {
        const int n0 = nc * 24, col = lane & 31, par = lane >> 5; const bool act = col < 24;
        float a0 = 0.f, a1 = 0.f, a2 = 0.f, a3 = 0.f;
#pragma unroll 8
        for (int i = 0; i < 64; ++i) { const int k = wave * 128 + 2 * i + par; const float w = act ? __builtin_nontemporal_load(w_ada + (size_t)k * NADA + n0 + col) : 0.f;
            a0 += sc[k] * w; a1 += sc[D + k] * w; a2 += sc[2 * D + k] * w; a3 += sc[3 * D + k] * w; }
        a0 += __shfl_xor(a0, 32); a1 += __shfl_xor(a1, 32); a2 += __shfl_xor(a2, 32); a3 += __shfl_xor(a3, 32);
        if (lane < 32) { red[(wave * 4 + 0) * 32 + col] = a0; red[(wave * 4 + 1) * 32 + col] = a1; red[(wave * 4 + 2) * 32 + col] = a2; red[(wave * 4 + 3) * 32 + col] = a3; }
        __syncthreads();
        if (tid < 128) { const int b = tid >> 5, cc = tid & 31;
            if (cc < 24) { float s = b_ada[n0 + cc];
#pragma unroll
                for (int w = 0; w < 8; ++w) s += red[(w * 4 + b) * 32 + cc];
                __hip_atomic_store(mod + b * NADA + n0 + cc, s, __ATOMIC_RELAXED, __HIP_MEMORY_SCOPE_AGENT); } }
        asm volatile("s_waitcnt vmcnt(0)" ::: "memory");
        __syncthreads();
        if (tid == 0) __hip_atomic_fetch_add(modctr, 1u, __ATOMIC_RELAXED, __HIP_MEMORY_SCOPE_AGENT);
    }
    float* scr = (float*)(smem + wave * 17408);
    const int gw = blockIdx.x * 8 + wave, NGW = G * 8;
    constexpr int I_IN = 16 * 64, I_GATE = 16 * 64, I_SQ = 16 * 32, I_UP = 16 * 176, I_DN = 44 * 32, I_PC = 4 * 8 * 64;
    constexpr int NITEMS = I_IN + I_GATE + 3 * I_SQ + I_UP + I_DN + I_PC;
    const int nj = (NITEMS - gw + NGW - 1) / NGW; const bool revo = ((wave >> 2) & 1) == 0;
    for (int jj = 0; jj < nj; ++jj) {
        const int it = gw + NGW * (revo ? nj - 1 - jj : jj);
        int r = it;
        if (r < I_IN) { const int nb = 64, kb = r / nb, n0 = (r % nb) * 32; transpose_item(a.in[5], D, 3 * D, (bf16_t*)(ws + WS_W1T), n0, kb * 64, n0, scr, lane); continue; } r -= I_IN;
        if (r < I_GATE) { const int nb = 64, kb = r / nb, n0 = (r % nb) * 32; transpose_item(a.in[15], D, 2 * D, (bf16_t*)(ws + WS_W1T), 3 * D + n0, kb * 64, n0, scr, lane); continue; } r -= I_GATE;
        if (r < I_SQ) { const int kb = r / 32, n0 = (r % 32) * 32; transpose_item(a.in[13], D, D, (bf16_t*)(ws + WS_WPA), n0, kb * 64, n0, scr, lane); continue; } r -= I_SQ;
        if (r < I_SQ) { const int kb = r / 32, n0 = (r % 32) * 32; transpose_item(a.in[14], D, D, (bf16_t*)(ws + WS_WPB), n0, kb * 64, n0, scr, lane); continue; } r -= I_SQ;
        if (r < I_SQ) { const int kb = r / 32, n0 = (r % 32) * 32; transpose_item(a.in[17], D, D, (bf16_t*)(ws + WS_WOUT), n0, kb * 64, n0, scr, lane); continue; } r -= I_SQ;
        if (r < I_UP) { const int nb = 176, kb = r / nb, n0 = (r % nb) * 32; const int half = n0 >= DFF ? 1 : 0, j = n0 - half * DFF;
            transpose_item(a.in[19], D, NUP, (bf16_t*)(ws + WS_WUP), (j >> 7) * 256 + half * 128 + (j & 127), kb * 64, n0, scr, lane); continue; } r -= I_UP;
        if (r < I_DN) { const int kb = r / 32, n0 = (r % 32) * 32; transpose_item(a.in[22], DFF, D, (bf16_t*)(ws + WS_WDN), n0, kb * 64, n0, scr, lane); continue; } r -= I_DN;
        {
            const int g = r >> 9, q = r & 511, n0 = (q >> 6) * 32, k0 = (q & 63) * 16, nn = lane & 31, kh = lane >> 5;
            float* At = (float*)(smem + wave * 17408);
            { const float* Ag = a.in[5] + (size_t)k0 * (3 * D) + 2 * D + g * 256; f32x4 av[16];
#pragma unroll
              for (int i = 0; i < 16; ++i) av[i] = *(const f32x4*)(Ag + (size_t)i * (3 * D) + 4 * lane);
#pragma unroll
              for (int i = 0; i < 16; ++i) *(f32x4*)(At + i * 260 + 4 * lane) = av[i]; }
            asm volatile("s_waitcnt lgkmcnt(0)" ::: "memory");
            const float* Bp = a.in[10] + (size_t)g * 65536 + n0 + nn;
            const float* Ar = At + (kh * 8) * 260;
            float accp[8];
#pragma unroll
            for (int i = 0; i < 8; ++i) accp[i] = 0.f;
#pragma unroll 2
            for (int c0 = 0; c0 < 256; c0 += 32) {
                float bv[32];
#pragma unroll
                for (int j = 0; j < 32; ++j) bv[j] = Bp[(size_t)(c0 + j) * 256];
#pragma unroll
                for (int i = 0; i < 8; ++i)
#pragma unroll
                    for (int j = 0; j < 32; j += 4) { const f32x4 a4 = *(const f32x4*)(Ar + i * 260 + c0 + j); accp[i] += (a4[0] * bv[j] + a4[1] * bv[j + 1]) + (a4[2] * bv[j + 2] + a4[3] * bv[j + 3]); }
            }
            u32x4 o; o.x = cvt_pk_bf16(accp[0], accp[1]); o.y = cvt_pk_bf16(accp[2], accp[3]); o.z = cvt_pk_bf16(accp[4], accp[5]); o.w = cvt_pk_bf16(accp[6], accp[7]);
            *(u32x4*)((bf16_t*)(ws + WS_W1T) + (size_t)(2 * D + g * 256 + n0 + nn) * D + k0 + kh * 8) = o;
            asm volatile("s_waitcnt lgkmcnt(0)" ::: "memory");
        }
    }
    { const float* wsp = a.in[8]; bf16_t* o = (bf16_t*)(ws + WS_WSP);
      for (int i = blockIdx.x * 512 + tid; i < 8 * 128 * 128 / 2; i += G * 512) { const int e = 2 * i, p = (e >> 7) & 127, q = e & 127; const bool ok = (q >> 6) <= (p >> 6);
          const f32x2 v = *(const f32x2*)(wsp + e); ((unsigned*)o)[i] = ok ? cvt_pk_bf16(v.x, v.y) : 0u; } }
    if (tid < 64) { unsigned sp = 0;
        while ((unsigned)__builtin_amdgcn_readfirstlane(__hip_atomic_load(modctr, __ATOMIC_RELAXED, __HIP_MEMORY_SCOPE_AGENT)) < (unsigned)(NADA / 24)) { __builtin_amdgcn_s_sleep(2); if (++sp > (1u << 22)) break; }
        __builtin_amdgcn_fence(__ATOMIC_ACQUIRE, "agent");
        asm volatile("s_waitcnt vmcnt(0)" ::: "memory"); }
    __syncthreads();
    const float* x = a.in[0]; const float* g1 = a.in[4]; bf16_t* H = (bf16_t*)(ws + WS_H);
    for (int rg = gw; rg < M / 8; rg += NGW) {
        const int r0 = rg * 8, b = r0 >> 12;
        f32x4 scl[4], sft[4];
#pragma unroll
        for (int j = 0; j < 4; ++j) { const int c = 4 * lane + 256 * j; scl[j] = *(const f32x4*)(g1 + c) * (*(const f32x4*)(mod + b * NADA + D + c) + 1.0f); sft[j] = *(const f32x4*)(mod + b * NADA + c); }
#pragma unroll 2
        for (int r = 0; r < 8; ++r) {
            const float* xr = x + (size_t)(r0 + r) * D + 4 * lane; f32x4 v[4]; float ss = 0.f;
#pragma unroll
            for (int j = 0; j < 4; ++j) { v[j] = __builtin_nontemporal_load((const f32x4*)(xr + 256 * j)); ss += (v[j][0] * v[j][0] + v[j][1] * v[j][1]) + (v[j][2] * v[j][2] + v[j][3] * v[j][3]); }
            const float rstd = __builtin_amdgcn_rsqf(wave_sum(ss) * (1.0f / D) + EPS);
            bf16_t* hr = H + (size_t)(r0 + r) * D + 4 * lane;
#pragma unroll
            for (int j = 0; j < 4; ++j) { const f32x4 o = v[j] * rstd * scl[j] + sft[j]; u32x2 w; w.x = cvt_pk_bf16(o[0], o[1]); w.y = cvt_pk_bf16(o[2], o[3]); *(u32x2*)(hr + 256 * j) = w; }
        }
    }
}

__device__ __forceinline__ void phase1(const Args& a, unsigned char* smem) {
    const int tid = tid_opaque(), lane = tid & 63, wave = tid >> 6, G = gridDim.x;
    unsigned char* ws = a.ws; const float* mod = (const float*)(ws + WS_MOD);
    const float* x = a.in[0]; const float* g1 = a.in[4]; bf16_t* H = (bf16_t*)(ws + WS_H);
    const int gw = blockIdx.x * 8 + wave, NGW = G * 8;
    float* sh2 = (float*)smem;
    for (int i = tid; i < 4 * D; i += 512) sh2[i] = mod[(i >> 10) * NADA + 3 * D + (i & 1023)];
    __syncthreads();
    const bf16_t* Wup = (const bf16_t*)(ws + WS_WUP); const float* convw = a.in[20]; const float* convb = a.in[21];
    float* cb = (float*)(ws + WS_CB); float* cw = (float*)(ws + WS_CW);
    for (int np = gw; np < NUP; np += NGW) {
        float d0 = 0.f, d1 = 0.f, d2 = 0.f, d3 = 0.f;
#pragma unroll
        for (int j = 0; j < 2; ++j) { const int k0 = 8 * lane + 512 * j; const u32x4 w = *(const u32x4*)(Wup + (size_t)np * D + k0);
#pragma unroll
            for (int e = 0; e < 4; ++e) { const float lo = bf_lo(w[e]), hi = bf_hi(w[e]); const int k = k0 + 2 * e;
                d0 += lo * sh2[k] + hi * sh2[k + 1]; d1 += lo * sh2[D + k] + hi * sh2[D + k + 1]; d2 += lo * sh2[2 * D + k] + hi * sh2[2 * D + k + 1]; d3 += lo * sh2[3 * D + k] + hi * sh2[3 * D + k + 1]; } }
        d0 = wave_sum(d0); d1 = wave_sum(d1); d2 = wave_sum(d2); d3 = wave_sum(d3);
        const int pn = np >> 8, r = np & 255, half = r >> 7, jl = r & 127, n = half * DFF + pn * 128 + jl;
        const float w0 = convw[n], w1 = convw[NUP + n], w2 = convw[2 * NUP + n], cbv = convb[n];
        if (lane < 12) { const int sidx = lane >> 2, b = lane & 3; const float sw = sidx == 0 ? w2 : (sidx == 1 ? w1 + w2 : w0 + w1 + w2); const float dv = b == 0 ? d0 : (b == 1 ? d1 : (b == 2 ? d2 : d3));
            cb[(size_t)(sidx * 4 + b) * NUP + np] = cbv + dv * sw; }
        else if (lane < 15) { const int k = lane - 12; cw[k * NUP + np] = k == 0 ? w0 : (k == 1 ? w1 : w2); }
    }
}

__device__ __forceinline__ void phase3(const Args& a, unsigned char* smem) {
    const int G = gridDim.x;
    unsigned char* ws = a.ws;
    bf16_t* U = (bf16_t*)(ws + WS_U); const bf16_t* V = (const bf16_t*)(ws + WS_V); const bf16_t* ZB = (const bf16_t*)(ws + WS_ZB); bf16_t* YB = (bf16_t*)(ws + WS_H);
    const float* vst = (const float*)(ws + WS_VST);
    const bf16_t* Wsp = (const bf16_t*)(ws + WS_WSP);
    const float* lng = a.in[6]; const float* lnb = a.in[7]; const float* bsp = a.in[9]; const float* bpool = a.in[11]; const float* pscale = a.in[12];
#ifndef REP_POOL
#define REP_POOL 1
#endif
#ifndef REP_SPAT
#define REP_SPAT 1
#endif
    for (int it0 = blockIdx.x; it0 < REP_POOL * 512 + REP_SPAT * 1024; it0 += G) {
        int it = it0 < REP_POOL * 512 ? (it0 & 511) : it0 - (REP_POOL - 1) * 512; bool do_store = true;
        if (it >= 512 + 1024) { it -= 1024; do_store = (a.use_cg == 77); }
        __syncthreads();
        const int tid = tid_opaque(), lane = tid & 63, wave = tid >> 6, wr = wave >> 2, wc = wave & 3, fr = lane & 15, fq = lane >> 4;
        if (it < 512) {
            const int tb = it >> 2, g = it & 3, m0 = tb * 128, c0 = g * 256, w = 2 << g, sqm0 = m0 & (SEQ - 1);
            bf16_t* Raw = (bf16_t*)smem;
            {   u32x4 zr[9];
#pragma unroll
                for (int j = 0; j < 9; ++j) { const int idx = tid + 512 * j, r = idx >> 5, cc = idx & 31;
                    zr[j] = (u32x4){0u, 0u, 0u, 0u};
                    if (r >= 16 || sqm0 != 0) zr[j] = *(const u32x4*)(ZB + (size_t)(m0 - 16 + r) * D + c0 + cc * 8); }
#pragma unroll
                for (int j = 0; j < 9; ++j) { const int idx = tid + 512 * j, r = idx >> 5, cc = idx & 31; *(u32x4*)(Raw + r * 264 + cc * 8) = zr[j]; }
            }
            const int cc = tid & 31, strip = tid >> 5, lr0 = strip * 8;
            const f32x4 bp0 = *(const f32x4*)(bpool + c0 + cc * 8), bp1 = *(const f32x4*)(bpool + c0 + cc * 8 + 4), ps0 = *(const f32x4*)(pscale + c0 + cc * 8), ps1 = *(const f32x4*)(pscale + c0 + cc * 8 + 4);
            __syncthreads();
            { const bf16_t* rp = Raw + (lr0 + 16) * 264 + cc * 8;
              float sum[8];
#pragma unroll
              for (int e = 0; e < 8; ++e) sum[e] = 0.f;
              for (int j = 1; j < w; ++j) { const u32x4 z = *(const u32x4*)(rp - j * 264);
#pragma unroll
                  for (int e = 0; e < 4; ++e) { sum[2 * e] += bf_lo(z[e]); sum[2 * e + 1] += bf_hi(z[e]); } }
#pragma unroll
              for (int i = 0; i < 8; ++i) {
                  const u32x4 z = *(const u32x4*)(rp + i * 264); const int sq = sqm0 + lr0 + i; const float inv = 1.0f / (float)(sq + 1 < w ? sq + 1 : w);
                  float o[8];
#pragma unroll
                  for (int e = 0; e < 4; ++e) { const float lo = bf_lo(z[e]), hi = bf_hi(z[e]); sum[2 * e] += lo; sum[2 * e + 1] += hi; o[2 * e] = sum[2 * e] * inv - lo; o[2 * e + 1] = sum[2 * e + 1] * inv - hi; }
#pragma unroll
                  for (int e = 0; e < 8; ++e) o[e] = (o[e] + (e < 4 ? bp0[e & 3] : bp1[e & 3])) * (e < 4 ? ps0[e & 3] : ps1[e & 3]);
                  u32x4 pw; pw.x = cvt_pk_bf16(o[0], o[1]); pw.y = cvt_pk_bf16(o[2], o[3]); pw.z = cvt_pk_bf16(o[4], o[5]); pw.w = cvt_pk_bf16(o[6], o[7]);
                  *(u32x4*)(YB + (size_t)(m0 + lr0 + i) * D + c0 + cc * 8) = pw;
                  const u32x4 zo = *(const u32x4*)(rp + (i - (w - 1)) * 264);
#pragma unroll
                  for (int e = 0; e < 4; ++e) { sum[2 * e] -= bf_lo(zo[e]); sum[2 * e + 1] -= bf_hi(zo[e]); }
              } }
        } else {
            const int si = it - 512, nb = si >> 3, g = si & 7, m0 = nb * 128, c0 = g * 128;
            bf16_t* vT = (bf16_t*)smem;
            float* st = (float*)(smem + 36864);
            const int kmax = wr == 0 ? 2 : 4;
            const bf16_t* Ap = Wsp + (size_t)g * 16384 + (size_t)(64 * wr + fr) * 128 + 8 * fq;
            bf16x8 Af[4][4];
#pragma unroll
            for (int ks = 0; ks < 4; ++ks)
#pragma unroll
                for (int m = 0; m < 4; ++m) Af[ks][m] = (ks < kmax) ? *(const bf16x8*)(Ap + m * 16 * 128 + ks * 32) : (bf16x8){0, 0, 0, 0, 0, 0, 0, 0};
            const int d0 = (tid & 15) * 8;
            u32x4 zv[4];
#pragma unroll
            for (int j = 0; j < 4; ++j) zv[j] = *(const u32x4*)(V + (size_t)(m0 + ((tid + 512 * j) >> 4)) * D + c0 + d0);
            u32x4 uu[4];
#pragma unroll
            for (int m = 0; m < 4; ++m) uu[m] = *(const u32x4*)(U + (size_t)(m0 + 64 * wr + 16 * m + fr) * D + c0 + 32 * wc + 8 * fq);
            const f32x4 ga = *(const f32x4*)(lng + c0 + d0), gb2 = *(const f32x4*)(lng + c0 + d0 + 4), ba = *(const f32x4*)(lnb + c0 + d0), bb = *(const f32x4*)(lnb + c0 + d0 + 4);
            if (tid < 128) { const f32x4* p = (const f32x4*)(vst + (size_t)(m0 + tid) * 32); float sm = 0.f, q = 0.f;
#pragma unroll
                for (int j = 0; j < 8; ++j) { const f32x4 t = p[j]; sm += t[0] + t[2]; q += t[1] + t[3]; }
                const float mu = sm * (1.0f / D), var = q * (1.0f / D) - mu * mu; st[2 * tid] = mu; st[2 * tid + 1] = __builtin_amdgcn_rsqf(var + EPS); }
            __syncthreads();
#pragma unroll
            for (int j = 0; j < 4; ++j) { const int q = (tid + 512 * j) >> 4;
                const u32x4 z = zv[j]; const float mu = st[2 * q], rs = st[2 * q + 1];
                float o[8];
#pragma unroll
                for (int e = 0; e < 4; ++e) { o[2 * e] = bf_lo(z[e]); o[2 * e + 1] = bf_hi(z[e]); }
#pragma unroll
                for (int e = 0; e < 8; ++e) { const float gg = e < 4 ? ga[e & 3] : gb2[e & 3], bbv = e < 4 ? ba[e & 3] : bb[e & 3]; const float y = (o[e] - mu) * rs * gg + bbv;
                    const int d = d0 + e, sw = ((d >> 3) ^ d) & 15;
                    vT[d * 128 + ((((q >> 3) ^ sw) << 3) | (q & 7))] = (bf16_t)(cvt_pk_bf16(y, 0.f) & 0xffffu); } }
            __syncthreads();
            f32x4 acc[4][2];
#pragma unroll
            for (int m = 0; m < 4; ++m)
#pragma unroll
                for (int n = 0; n < 2; ++n) acc[m][n] = (f32x4){0.f, 0.f, 0.f, 0.f};
#pragma unroll
            for (int ks = 0; ks < 4; ++ks) {
                if (ks < kmax) {
                    bf16x8 Bf[2];
#pragma unroll
                    for (int n = 0; n < 2; ++n) { const int d = 32 * wc + 8 * (fr >> 2) + 4 * n + (fr & 3), sw = ((d >> 3) ^ d) & 15; Bf[n] = *(const bf16x8*)(vT + d * 128 + (((ks * 4 + fq) ^ sw) << 3)); }
#pragma unroll
                    for (int m = 0; m < 4; ++m)
#pragma unroll
                        for (int n = 0; n < 2; ++n) acc[m][n] = __builtin_amdgcn_mfma_f32_16x16x32_bf16(Bf[n], Af[ks][m], acc[m][n], 0, 0, 0);
                }
            }
#pragma unroll
            for (int m = 0; m < 4; ++m) { const int p = 64 * wr + 16 * m + fr; const float bs = bsp[g * 128 + p];
                { bf16_t* up = U + (size_t)(m0 + p) * D + c0 + 32 * wc + 8 * fq; const u32x4 uv = uu[m];
                    u32x4 o;
                    o.x = cvt_pk_bf16(bf_lo(uv.x) * (acc[m][0][0] + bs), bf_hi(uv.x) * (acc[m][0][1] + bs)); o.y = cvt_pk_bf16(bf_lo(uv.y) * (acc[m][0][2] + bs), bf_hi(uv.y) * (acc[m][0][3] + bs));
                    o.z = cvt_pk_bf16(bf_lo(uv.z) * (acc[m][1][0] + bs), bf_hi(uv.z) * (acc[m][1][1] + bs)); o.w = cvt_pk_bf16(bf_lo(uv.w) * (acc[m][1][2] + bs), bf_hi(uv.w) * (acc[m][1][3] + bs));
                    if (do_store) *(u32x4*)up = o; } }
        }
    }
}

__device__ __forceinline__ void phase9(const Args& a) {
    const int tid = tid_opaque(), lane = tid & 63, wave = tid >> 6, G = gridDim.x;
    const float* ss3 = (const float*)(a.ws + WS_SS3); const float* gf = a.in[23]; float* out = a.out;
    const int gw = blockIdx.x * 8 + wave, NGW = G * 8;
    f32x4 gv[4];
#pragma unroll
    for (int j = 0; j < 4; ++j) gv[j] = *(const f32x4*)(gf + 4 * lane + 256 * j);
    for (int row0 = gw * 4; row0 < M; row0 += NGW * 4) {
        f32x4 v[4][4]; float rstd[4];
#pragma unroll
        for (int r = 0; r < 4; ++r) {
            const f32x4* p = (const f32x4*)(ss3 + (size_t)(row0 + r) * 16); const f32x4 st = (p[0] + p[1]) + (p[2] + p[3]);
            rstd[r] = __builtin_amdgcn_rsqf(((st[0] + st[1]) + (st[2] + st[3])) * (1.0f / D) + EPS);
            const float* xr = out + (size_t)(row0 + r) * D + 4 * lane;
#pragma unroll
            for (int j = 0; j < 4; ++j) v[r][j] = *(const f32x4*)(xr + 256 * j);
        }
#pragma unroll
        for (int r = 0; r < 4; ++r) { float* xr = out + (size_t)(row0 + r) * D + 4 * lane;
#pragma unroll
            for (int j = 0; j < 4; ++j) *(f32x4*)(xr + 256 * j) = v[r][j] * rstd[r] * gv[j]; }
    }
}

__global__ void __launch_bounds__(512, 2) fwd_megakernel(Args a) {
    extern __shared__ __attribute__((aligned(16))) unsigned char smem[];
    cg::grid_group grid = cg::this_grid();
    LAS unsigned char* lds = (LAS unsigned char*)smem;
    unsigned char* ws = a.ws;
    const int G = gridDim.x, bx = blockIdx.x;

#ifndef PH_MASK
#define PH_MASK 0xFFFF
#endif
#ifndef REP_P0
#define REP_P0 1
#endif
#ifndef REP_P1
#define REP_P1 1
#endif
#ifndef REP_G1
#define REP_G1 1
#endif
#ifndef REP_G2
#define REP_G2 1
#endif
#ifndef REP_G3
#define REP_G3 1
#endif
#ifndef REP_G4
#define REP_G4 1
#endif
#ifndef REP_SYNC
#define REP_SYNC 1
#endif
#define GSYNC() do { for (int _r = 0; _r < REP_SYNC; ++_r) { if (a.use_cg) grid.sync(); else xcd_barrier(xbar); } } while (0)
    volatile LAS unsigned* xst = (volatile LAS unsigned*)(lds + LDS_BYTES - 64);
    if (threadIdx.x < 2) xst[threadIdx.x] = 0u;
    __syncthreads();
    const XcdBarrier xbar = xcd_barrier_post((unsigned*)(ws + WS_CTL), xst);
    for (int rep = 0; rep < REP_P0; ++rep) { phase0(a, smem); __syncthreads(); }
    GSYNC();
    for (int rep = 0; rep < REP_G1; ++rep) {
        pg8::Gemm g; g.A0 = g.A1 = (const bf16_t*)(ws + WS_H); g.B0 = g.B1 = (const bf16_t*)(ws + WS_W1T); g.K = D; g.mstride = 256;
        pg8::TileOrder S; S.init(M / 256, N1 / 256, G, bx, 0);
        Epi1 E{(bf16_t*)(ws + WS_U), (bf16_t*)(ws + WS_V), (bf16_t*)(ws + WS_ZB), (bf16_t*)(ws + WS_G), a.in[16], (float*)(ws + WS_VST)};
        pg8::gemm_phase(lds, g, S, E);
    }
    if (a.use_cg) { grid.sync(); phase1(a, smem); __syncthreads(); }
    else { xcd_barrier_arrive(xbar); phase1(a, smem); xcd_barrier_wait(xbar); }
    phase3(a, smem);
    GSYNC();
    for (int rep = 0; rep < REP_G2; ++rep) {
        pg8::Gemm g; g.A0 = (const bf16_t*)(ws + WS_U); g.A1 = (const bf16_t*)(ws + WS_H); g.B0 = (const bf16_t*)(ws + WS_WPA); g.B1 = (const bf16_t*)(ws + WS_WPB); g.K = D; g.mstride = 256;
        pg8::TileOrder S; S.init(M / 256, D / 256, G, bx, 1);
        Epi2 E{(const bf16_t*)(ws + WS_G), (bf16_t*)(ws + WS_V)};
        pg8::gemm_phase(lds, g, S, E);
    }
    GSYNC();
    for (int rep = 0; rep < REP_G3; ++rep) {
        pg8::Gemm g; g.A0 = g.A1 = (const bf16_t*)(ws + WS_V); g.B0 = g.B1 = (const bf16_t*)(ws + WS_WOUT); g.K = D; g.mstride = 256;
        pg8::TileOrder S; S.init(M / 256, D / 256, G, bx, 0);
        EpiRes<true> E{a.in[0], a.out, (bf16_t*)(ws + WS_H), (const float*)(ws + WS_MOD), 2 * D, a.in[18], (float*)(ws + WS_SS2), G == (M / 256) * (D / 256) ? (bf16_t*)(ws + WS_G) : nullptr};
        pg8::gemm_phase(lds, g, S, E);
    }
    GSYNC();
    for (int rep = 0; rep < REP_G4; ++rep) {
        pg8::Gemm g; g.A0 = g.A1 = (const bf16_t*)(ws + WS_H) - (size_t)2 * D; g.B0 = g.B1 = (const bf16_t*)(ws + WS_WUP); g.K = D; g.mstride = MT4;
        pg8::TileOrder S; S.init(NM4, NUP / 256, G, bx, 0);
        int pre = 0;
        { Unit pu; if (!S.next(6, pu)) {
              const int t = tid_opaque(); LAS float* rsBig = (LAS float*)(lds + LDS_HALO + 8192);
              if (t < 256) {
#pragma unroll
                  for (int i = 0; i < 6; ++i) if (S.next(i, pu)) { int gr = pu.pm * MT4 - 2 + t; gr = gr < 0 ? 0 : (gr > M - 1 ? M - 1 : gr);
                      const f32x4* p = (const f32x4*)((const float*)(ws + WS_SS2) + (size_t)gr * 16); const f32x4 st = (p[0] + p[1]) + (p[2] + p[3]);
                      rsBig[i * 256 + t] = __builtin_amdgcn_rsqf(((st[0] + st[1]) + (st[2] + st[3])) * (1.0f / D) + EPS); } }
              pre = 6; __syncthreads(); } }
        Epi4 E{(const float*)(ws + WS_SS2), (const float*)(ws + WS_CB), (const float*)(ws + WS_CW), (bf16_t*)(ws + WS_F), pre};
        pg8::gemm_phase(lds, g, S, E);
    }
    GSYNC();
    if (G == (M / 256) * (D / 256)) {
        pg8::Gemm g; g.A0 = g.A1 = (const bf16_t*)(ws + WS_F); g.B0 = g.B1 = (const bf16_t*)(ws + WS_WDN); g.K = DFF; g.mstride = 256;
        pg8::TileOrder S; S.init(M / 256, D / 256, G, bx, 0);
        EpiTail E{a.out, (const float*)(ws + WS_MOD), a.in[23], (float*)(ws + WS_VST), (unsigned*)(ws + WS_CTL + 16384), (const bf16_t*)(ws + WS_G)};
        pg8::gemm_phase(lds, g, S, E);
        return;
    }
    {
        pg8::Gemm g; g.A0 = g.A1 = (const bf16_t*)(ws + WS_F); g.B0 = g.B1 = (const bf16_t*)(ws + WS_WDN); g.K = DFF; g.mstride = 256;
        pg8::TileOrder S; S.init(M / 256, D / 256, G, bx, 0);
        EpiRes<false> E{a.out, a.out, nullptr, (const float*)(ws + WS_MOD), 5 * D, nullptr, (float*)(ws + WS_SS3), nullptr};
        pg8::gemm_phase(lds, g, S, E);
    }
    GSYNC();
    phase9(a);
}

extern "C" void kernel_launch(void* const* d_in, const int* in_sizes, int n_in, void* d_out, int out_size, void* d_ws, size_t ws_size, hipStream_t stream) {
    static int grid = 0;
    if (grid == 0) {
        int dev = 0, cus = 0, per_cu = 0;
        hipGetDevice(&dev);
        hipDeviceGetAttribute(&cus, hipDeviceAttributeMultiprocessorCount, dev);
        hipFuncSetAttribute((const void*)fwd_megakernel, hipFuncAttributeMaxDynamicSharedMemorySize, LDS_BYTES);
        hipOccupancyMaxActiveBlocksPerMultiprocessor(&per_cu, (const void*)fwd_megakernel, 512, LDS_BYTES);
        if (per_cu < 1) { fprintf(stderr, "kernel_launch: occupancy query says %d blocks per CU\n", per_cu); per_cu = 1; }
        grid = cus * per_cu;
    }
    if (hipMemsetAsync((char*)d_ws + WS_CTL, 0, CTL_BYTES, stream) != hipSuccess) fprintf(stderr, "kernel_launch: memset of the barrier words failed\n");
    Args a{};
    for (int i = 0; i < 24; ++i) a.in[i] = (const float*)d_in[i];
    a.out = (float*)d_out; a.ws = (unsigned char*)d_ws;
    void* args[] = {&a};
    hipError_t e = hipLaunchCooperativeKernel((const void*)fwd_megakernel, dim3(grid), dim3(512), args, LDS_BYTES, stream);
    if (e != hipSuccess) fprintf(stderr, "cooperative launch failed: %s (grid %d)\n", hipGetErrorString(e), grid);
}
```

```cpp
#include <hip/hip_runtime.h>
#include <hip/hip_cooperative_groups.h>
#include <cstdio>
#include <cstdint>
namespace cg = cooperative_groups;

#define LAS __attribute__((address_space(3)))
typedef unsigned short bf16_t;
typedef short bf16x8 __attribute__((ext_vector_type(8)));
typedef float f32x4 __attribute__((ext_vector_type(4)));
typedef float f32x2 __attribute__((ext_vector_type(2)));
typedef unsigned u32x4 __attribute__((ext_vector_type(4)));
typedef unsigned u32x2 __attribute__((ext_vector_type(2)));

constexpr int D = 1024, BATCH = 4, SEQ = 4096, M = BATCH * SEQ, DFF = 2816, NUP = 2 * DFF, NADA = 6 * D;
constexpr int N1 = 3 * D + 2 * D;
constexpr float EPS = 1e-6f;
constexpr int MT4 = 254, NM4 = 65;

constexpr size_t MiB = 1u << 20;
constexpr size_t WS_MOD = 0;
constexpr size_t WS_CB = 128 * 1024;
constexpr size_t WS_CW = 512 * 1024;
constexpr size_t WS_VST = 1 * MiB;
constexpr size_t WS_SS2 = 3 * MiB;
constexpr size_t WS_SS3 = 4 * MiB;
constexpr size_t WS_WSP = 5 * MiB;
constexpr size_t WS_WPOOL = 5 * MiB + 512 * 1024;
constexpr size_t WS_W1T = 6 * MiB;
constexpr size_t WS_WPA = 16 * MiB, WS_WPB = 18 * MiB, WS_WOUT = 20 * MiB;
constexpr size_t WS_WUP = 22 * MiB;
constexpr size_t WS_WDN = 33 * MiB;
constexpr size_t WS_H = 40 * MiB;
constexpr size_t WS_U = 72 * MiB;
constexpr size_t WS_V = 104 * MiB;
constexpr size_t WS_ZB = 136 * MiB;
constexpr size_t WS_G = 168 * MiB;
constexpr size_t WS_CTL = 240 * MiB, CTL_BYTES = 64 * 1024;
constexpr size_t WS_F = 72 * MiB;

constexpr int LDS_HALO = 131072;
constexpr int LDS_BYTES = 147456;

__device__ __forceinline__ unsigned cvt_pk_bf16(float lo, float hi) { unsigned r; asm("v_cvt_pk_bf16_f32 %0, %1, %2" : "=v"(r) : "v"(lo), "v"(hi)); return r; }
__device__ __forceinline__ float bf_lo(unsigned w) { return __uint_as_float(w << 16); }
__device__ __forceinline__ float bf_hi(unsigned w) { return __uint_as_float(w & 0xffff0000u); }
__device__ __forceinline__ float wave_sum(float v) {
#pragma unroll
    for (int o = 1; o < 64; o <<= 1) v += __shfl_xor(v, o);
    return v;
}
__device__ __forceinline__ int tid_opaque() { int t = threadIdx.x; asm volatile("" : "+v"(t)); return t; }
__device__ __forceinline__ float sigmoid_f(float x) { return __builtin_amdgcn_rcpf(1.0f + __builtin_amdgcn_exp2f(-1.4426950408889634f * x)); }
__device__ __forceinline__ f32x2 gelu_pk(f32x2 v) {
    const f32x2 av = __builtin_elementwise_abs(v), d = av * 0.2316418882f + 1.0f;
    f32x2 t; t.x = __builtin_amdgcn_rcpf(d.x); t.y = __builtin_amdgcn_rcpf(d.y);
    f32x2 q = t * 0.5307027145f + (-0.7265760135f); q = q * t + 0.7107068705f; q = q * t + (-0.142248368f); q = q * t + 0.127414796f; q = q * t;
    const f32x2 s = (v * v) * (-0.72134752044f);
    f32x2 e; e.x = __builtin_amdgcn_exp2f(s.x); e.y = __builtin_amdgcn_exp2f(s.y);
    const f32x2 m = v * (q * e), r = v - m;
    f32x2 o; o.x = v.x < 0.f ? m.x : r.x; o.y = v.y < 0.f ? m.y : r.y; return o;
}
__device__ __forceinline__ f32x4 gelu4(f32x4 v) { f32x2 a = gelu_pk((f32x2){v[0], v[1]}), b = gelu_pk((f32x2){v[2], v[3]}); return (f32x4){a.x, a.y, b.x, b.y}; }

namespace pg8 {
constexpr int BM = 256, BK = 64, HALF = 128, HTB = HALF * BK * 2, STAGE_BYTES = 8 * HTB, NXCD = 8, WGM = 2;
__host__ __device__ __forceinline__ int lds_byte(int r, int c) { const int st = (r >> 4) * 2 + (c >> 5), rr = r & 15, cc = c & 31, ob = rr * 64 + cc * 2; return st * 1024 + (ob ^ (((ob >> 9) & 1) << 5)); }
__host__ __device__ __forceinline__ void stage_rc(int b, int& R, int& C) { const int st = b / 1024, sb = b % 1024, swz = sb ^ (((sb >> 9) & 1) << 5); R = (st >> 1) * 16 + swz / 64; C = (st & 1) * 32 + (swz % 64) / 2; }
__host__ __device__ __forceinline__ int perm32(int rho) { const int n = rho >> 4, i = rho & 15; return 8 * (i >> 2) + 4 * n + (i & 3); }

struct Unit { int pm, pn, z, ord; };
struct Gemm { const bf16_t* A0; const bf16_t* A1; const bf16_t* B0; const bf16_t* B1; int K; int mstride; };

struct TileOrder {
    int nM, nN, nwg, G, c, ZS;
    __device__ void init(int nM_, int nN_, int G_, int c_, int ZS_) { nM = nM_; nN = nN_; nwg = nM * nN; G = G_; c = c_; ZS = ZS_; }
    __device__ bool next(int i, Unit& u) const {
        const int ti = i >> ZS; u.z = i & ((1 << ZS) - 1); u.ord = i;
        const long L = (long)ti * G + c; if (L >= nwg) return false;
        int wgid = (int)L; { const int q = nwg / NXCD, r = nwg % NXCD, xcd = wgid % NXCD, off = wgid / NXCD; wgid = (xcd < r ? xcd * (q + 1) : r * (q + 1) + (xcd - r) * q) + off; }
        const int nig = WGM * nN, gid = wgid / nig, fm = gid * WGM, gsz = (nM - fm) < WGM ? (nM - fm) : WGM;
        u.pm = fm + ((wgid % nig) % gsz); u.pn = (wgid % nig) / gsz; return true;
    }
};

template <class Epi, class Sched>
__device__ __forceinline__ void gemm_phase(LAS unsigned char* lds, const Gemm g, const Sched& S, const Epi& E) {
    const int tid = tid_opaque(), wid = __builtin_amdgcn_readfirstlane(tid >> 6), lane = tid & 63, wr = wid >> 2, wc = wid & 3, fr = lane & 15, fq = lane >> 4;
    const int K = g.K, nt = K / BK;
    unsigned voffA[2], voffB[2];
#pragma unroll
    for (int i = 0; i < 2; ++i) { int R, C; stage_rc(tid * 16 + i * 8192, R, C); const int Rb = Epi::PERM ? ((R & ~31) + perm32(R & 31)) : R;
        const int Ra = Epi::APERM ? ((R & ~63) + 4 * (R & 15) + ((R & 63) >> 4)) : R;
        voffA[i] = (unsigned)(Ra * K + C) * 2u; voffB[i] = (unsigned)(Rb * K + C) * 2u; }
    const size_t kstep = (size_t)(BK * 2);
    const size_t hstep = (size_t)HALF * K * 2;
    const size_t tstepB = 2 * hstep;
    const size_t tstepA = (size_t)g.mstride * K * 2;
    const unsigned ldsw = (unsigned)wid * 1024u;
    const int aoff = lds_byte(wr * 64 + fr, fq * 8), boff = lds_byte(wc * 32 + fr, fq * 8);
#define PG8_SA(b, h) (((b) * 2 + (h)) * HTB)
#define PG8_SB(b, h) ((4 + (b) * 2 + (h)) * HTB)
#define PG8_STAGE(bufoff, gbase, voff) do { _Pragma("unroll") for (int _i = 0; _i < 2; ++_i) \
        __builtin_amdgcn_global_load_lds((const unsigned*)((const char*)(gbase) + (voff)[_i]), (LAS unsigned*)(lds + (bufoff) + ldsw + _i * 8192), 16, 0, 0); } while (0)
#define PG8_LDA(dst, b, h) do { _Pragma("unroll") for (int m = 0; m < 4; ++m) _Pragma("unroll") for (int k = 0; k < 2; ++k) dst[m][k] = *(const LAS bf16x8*)(lds + PG8_SA(b, h) + aoff + m * 2048 + k * 1024); } while (0)
#define PG8_LDB(dst, b, h) do { _Pragma("unroll") for (int n = 0; n < 2; ++n) _Pragma("unroll") for (int k = 0; k < 2; ++k) dst[n][k] = *(const LAS bf16x8*)(lds + PG8_SB(b, h) + boff + n * 2048 + k * 1024); } while (0)
#define PG8_MMA(ai, bj, At, Bt) do { __builtin_amdgcn_s_setprio(1); _Pragma("unroll") for (int m = 0; m < 4; ++m) _Pragma("unroll") for (int n = 0; n < 2; ++n) _Pragma("unroll") for (int k = 0; k < 2; ++k) \
        acc[ai][bj][m][n] = __builtin_amdgcn_mfma_f32_16x16x32_bf16(Bt[n][k], At[m][k], acc[ai][bj][m][n], 0, 0, 0); __builtin_amdgcn_s_setprio(0); } while (0)
#define PG8_WAIT_V(n) asm volatile("s_waitcnt vmcnt(" #n ")" ::: "memory")
#define PG8_WAIT_L(n) asm volatile("s_waitcnt lgkmcnt(" #n ")" ::: "memory")
#define PG8_BAR __builtin_amdgcn_s_barrier()
#define PG8_SCHED __builtin_amdgcn_sched_barrier(0)
    Unit cur, nxt; int ui = 0;
    if (!S.next(0, cur)) return;
    f32x4 acc[2][2][4][2];
#pragma unroll
    for (int a = 0; a < 2; ++a)
#pragma unroll
        for (int b = 0; b < 2; ++b)
#pragma unroll
            for (int m = 0; m < 4; ++m)
#pragma unroll
                for (int n = 0; n < 2; ++n) acc[a][b][m][n] = (f32x4){0.f, 0.f, 0.f, 0.f};
    bf16x8 At[4][2], B0[2][2], B1[2][2];
    const char* cA = (const char*)(cur.z ? g.A1 : g.A0) + (size_t)cur.pm * tstepA; const char* cB = (const char*)(cur.z ? g.B1 : g.B0) + (size_t)cur.pn * tstepB;
    PG8_STAGE(PG8_SB(0, 0), cB, voffB); PG8_STAGE(PG8_SB(0, 1), cB + hstep, voffB); PG8_STAGE(PG8_SA(0, 0), cA, voffA); PG8_STAGE(PG8_SA(0, 1), cA + hstep, voffA);
    if (wr == 1) PG8_BAR;
    PG8_WAIT_V(2); PG8_BAR;
    PG8_STAGE(PG8_SB(1, 0), cB + kstep, voffB); PG8_STAGE(PG8_SA(1, 0), cA + kstep, voffA); PG8_STAGE(PG8_SB(1, 1), cB + hstep + kstep, voffB);
    PG8_WAIT_V(6); PG8_BAR;
    for (;;) {
        const bool has_next = S.next(ui + 1, nxt);
        const char* nA = has_next ? (const char*)(nxt.z ? g.A1 : g.A0) + (size_t)nxt.pm * tstepA : cA; const char* nB = has_next ? (const char*)(nxt.z ? g.B1 : g.B0) + (size_t)nxt.pn * tstepB : cB;
        for (int t = 0; t < nt; t += 2) {
            const bool last = (t == nt - 2);
            const char* a1 = cA + (size_t)(t + 1) * kstep;
            const char* a2 = last ? nA : cA + (size_t)(t + 2) * kstep; const char* b2 = last ? nB : cB + (size_t)(t + 2) * kstep;
            const char* a3 = a2 + kstep; const char* b3 = b2 + kstep;
            PG8_LDB(B0, 0, 0); PG8_LDB(B1, 0, 1); PG8_SCHED; PG8_LDA(At, 0, 0); PG8_STAGE(PG8_SA(1, 1), a1 + hstep, voffA);
            PG8_WAIT_V(8); PG8_WAIT_L(0); PG8_BAR; PG8_MMA(0, 0, At, B0); PG8_MMA(0, 1, At, B1); PG8_BAR; PG8_SCHED;
            PG8_LDA(At, 0, 1); PG8_STAGE(PG8_SB(0, 0), b2, voffB); PG8_STAGE(PG8_SB(0, 1), b2 + hstep, voffB); PG8_STAGE(PG8_SA(0, 0), a2, voffA);
            PG8_WAIT_V(8); PG8_WAIT_L(0); PG8_BAR; PG8_MMA(1, 0, At, B0); PG8_MMA(1, 1, At, B1); PG8_BAR; PG8_SCHED;
            PG8_LDB(B0, 1, 0); PG8_LDB(B1, 1, 1); PG8_SCHED; PG8_LDA(At, 1, 0); PG8_STAGE(PG8_SA(0, 1), a2 + hstep, voffA);
            PG8_WAIT_V(8); PG8_WAIT_L(0); PG8_BAR; PG8_MMA(0, 0, At, B0); PG8_MMA(0, 1, At, B1); PG8_BAR; PG8_SCHED;
            PG8_LDA(At, 1, 1); PG8_STAGE(PG8_SB(1, 0), b3, voffB); PG8_STAGE(PG8_SB(1, 1), b3 + hstep, voffB); PG8_STAGE(PG8_SA(1, 0), a3, voffA);
            PG8_WAIT_V(8); PG8_WAIT_L(0); PG8_BAR; PG8_MMA(1, 0, At, B0); PG8_MMA(1, 1, At, B1); PG8_BAR; PG8_SCHED;
        }
        if (wr == 0) PG8_BAR;
        E(acc, cur, wr, wc, fr, fq, lds);
        if (!has_next) break;
        if (!E.keep(cur)) {
#pragma unroll
        for (int a = 0; a < 2; ++a)
#pragma unroll
            for (int b = 0; b < 2; ++b)
#pragma unroll
                for (int m = 0; m < 4; ++m)
#pragma unroll
                    for (int n = 0; n < 2; ++n) acc[a][b][m][n] = (f32x4){0.f, 0.f, 0.f, 0.f};
        }
        cur = nxt; cA = nA; cB = nB; ++ui;
        if (wr == 1) PG8_BAR;
    }
    PG8_WAIT_V(0);
    PG8_BAR;
#undef PG8_SA
#undef PG8_SB
#undef PG8_STAGE
#undef PG8_LDA
#undef PG8_LDB
#undef PG8_MMA
#undef PG8_WAIT_V
#undef PG8_WAIT_L
#undef PG8_BAR
#undef PG8_SCHED
}
}
using pg8::Unit;

struct Epi1 {
    static constexpr bool PERM = true, APERM = false;
    bf16_t *U, *V, *ZB, *G; const float* bgate; float* vst;
    __device__ __forceinline__ bool keep(const Unit&) const { return false; }
    __device__ __forceinline__ void operator()(f32x4 (&acc)[2][2][4][2], const Unit& u, int wr, int wc, int fr, int fq, LAS unsigned char*) const {
        const int seg = u.pn >> 2;
        const int row0 = u.pm * 256 + wr * 64 + fr;
        bf16_t* base; int ld, colt;
        if (seg == 0) { base = U; ld = D; colt = u.pn * 256; }
        else if (seg == 1) { base = V; ld = D; colt = (u.pn - 4) * 256; }
        else if (seg == 2) { base = ZB; ld = D; colt = (u.pn - 8) * 256; }
        else { base = G; ld = 2 * D; colt = (u.pn - 12) * 256; }
        const int col0 = colt + wc * 32 + 8 * fq;
        f32x4 bv[2][2];
#pragma unroll
        for (int bj = 0; bj < 2; ++bj)
#pragma unroll
            for (int n = 0; n < 2; ++n) bv[bj][n] = (seg >= 3) ? *(const f32x4*)(bgate + col0 + bj * 128 + 4 * n) : (f32x4){0.f, 0.f, 0.f, 0.f};
#pragma unroll
        for (int ai = 0; ai < 2; ++ai)
#pragma unroll
            for (int m = 0; m < 4; ++m) {
                const int row = row0 + ai * 128 + m * 16;
                bf16_t* rowp = base + (size_t)row * ld + col0;
                float s = 0.f, q = 0.f;
#pragma unroll
                for (int bj = 0; bj < 2; ++bj) {
                    f32x4 v0 = acc[ai][bj][m][0] + bv[bj][0], v1 = acc[ai][bj][m][1] + bv[bj][1];
                    if (seg <= 1) { v0 = gelu4(v0); v1 = gelu4(v1); }
                    else if (seg == 3) {
#pragma unroll
                        for (int j = 0; j < 4; ++j) { v0[j] = sigmoid_f(v0[j]); v1[j] = sigmoid_f(v1[j]); }
                    }
                    else if (seg == 4) {
#pragma unroll
                        for (int j = 0; j < 4; ++j) { v0[j] = 1.0f + __builtin_amdgcn_exp2f(-1.4426950408889634f * fmaxf(v0[j], -80.0f)); v1[j] = 1.0f + __builtin_amdgcn_exp2f(-1.4426950408889634f * fmaxf(v1[j], -80.0f)); }
                    }
                    if (seg == 1) {
#pragma unroll
                        for (int j = 0; j < 4; ++j) { s += v0[j] + v1[j]; q += v0[j] * v0[j] + v1[j] * v1[j]; }
                    }
                    u32x4 w; w.x = cvt_pk_bf16(v0[0], v0[1]); w.y = cvt_pk_bf16(v0[2], v0[3]); w.z = cvt_pk_bf16(v1[0], v1[1]); w.w = cvt_pk_bf16(v1[2], v1[3]);
                    *(u32x4*)(rowp + bj * 128) = w;
                }
                if (seg == 1) {
                    s += __shfl_xor(s, 16); s += __shfl_xor(s, 32); q += __shfl_xor(q, 16); q += __shfl_xor(q, 32);
                    if (fq == 0) *(f32x2*)(vst + ((size_t)row * 16 + (u.pn - 4) * 4 + wc) * 2) = (f32x2){s, q};
                }
            }
    }
};
struct Epi2 {
    static constexpr bool PERM = true, APERM = false;
    const bf16_t* G; bf16_t* O;
    __device__ __forceinline__ bool keep(const Unit& u) const { return u.z == 0; }
    __device__ __forceinline__ void operator()(f32x4 (&acc)[2][2][4][2], const Unit& u, int wr, int wc, int fr, int fq, LAS unsigned char*) const {
        const int row0 = u.pm * 256 + wr * 64 + fr, col0 = u.pn * 256 + wc * 32 + 8 * fq;
        if (u.z == 0) {
#pragma unroll
            for (int ai = 0; ai < 2; ++ai)
#pragma unroll
                for (int m = 0; m < 4; ++m) {
                    const bf16_t* gp = G + (size_t)(row0 + ai * 128 + m * 16) * (2 * D) + col0;
#pragma unroll
                    for (int bj = 0; bj < 2; ++bj) {
                        const u32x4 ga4 = *(const u32x4*)(gp + bj * 128), gb4 = *(const u32x4*)(gp + D + bj * 128);
#pragma unroll
                        for (int n = 0; n < 2; ++n) {
                            const unsigned gax = n ? ga4.z : ga4.x, gay = n ? ga4.w : ga4.y, gbx = n ? gb4.z : gb4.x, gby = n ? gb4.w : gb4.y;
                            f32x4 r;
                            r[0] = bf_lo(gax) * bf_lo(gbx); r[1] = bf_hi(gax) * bf_hi(gbx);
                            r[2] = bf_lo(gay) * bf_lo(gby); r[3] = bf_hi(gay) * bf_hi(gby);
                            acc[ai][bj][m][n] *= r;
                        }
                    }
                    if (m & 1) asm volatile("" ::: "memory");
                }
        } else {
#pragma unroll
            for (int ai = 0; ai < 2; ++ai)
#pragma unroll
                for (int m = 0; m < 4; ++m) {
                    const size_t row = (size_t)(row0 + ai * 128 + m * 16);
                    const bf16_t* gp = G + row * (2 * D) + D + col0;
#pragma unroll
                    for (int bj = 0; bj < 2; ++bj) {
                        const u32x4 gb = *(const u32x4*)(gp + bj * 128);
                        const f32x4 a0 = acc[ai][bj][m][0], a1 = acc[ai][bj][m][1];
                        u32x4 w;
                        w.x = cvt_pk_bf16(a0[0] * __builtin_amdgcn_rcpf(bf_lo(gb.x)), a0[1] * __builtin_amdgcn_rcpf(bf_hi(gb.x)));
                        w.y = cvt_pk_bf16(a0[2] * __builtin_amdgcn_rcpf(bf_lo(gb.y)), a0[3] * __builtin_amdgcn_rcpf(bf_hi(gb.y)));
                        w.z = cvt_pk_bf16(a1[0] * __builtin_amdgcn_rcpf(bf_lo(gb.z)), a1[1] * __builtin_amdgcn_rcpf(bf_hi(gb.z)));
                        w.w = cvt_pk_bf16(a1[2] * __builtin_amdgcn_rcpf(bf_lo(gb.w)), a1[3] * __builtin_amdgcn_rcpf(bf_hi(gb.w)));
                        *(u32x4*)(O + row * D + col0 + bj * 128) = w;
                    }
                    asm volatile("" ::: "memory");
                }
        }
    }
};
template <bool WITH_A2> struct EpiRes {
    static constexpr bool PERM = false, APERM = false;
    const float* xi; float* xo; bf16_t* a2; const float* mod; int gate_off; const float* g2; float* ss; bf16_t* x1b;
    __device__ __forceinline__ bool keep(const Unit&) const { return false; }
    __device__ __forceinline__ void operator()(f32x4 (&acc)[2][2][4][2], const Unit& u, int wr, int wc, int fr, int fq, LAS unsigned char*) const {
        const int b = (u.pm * 256) >> 12;
        const int row0 = u.pm * 256 + wr * 64 + fr, col0 = u.pn * 256 + wc * 32 + 4 * fq;
        f32x4 gt[2][2], sc[2][2];
#pragma unroll
        for (int bj = 0; bj < 2; ++bj)
#pragma unroll
            for (int n = 0; n < 2; ++n) {
                const int c = col0 + bj * 128 + n * 16;
                gt[bj][n] = *(const f32x4*)(mod + b * NADA + gate_off + c);
                if (WITH_A2) sc[bj][n] = *(const f32x4*)(g2 + c) * (*(const f32x4*)(mod + b * NADA + 4 * D + c) + 1.0f);
            }
#pragma unroll
        for (int ai = 0; ai < 2; ++ai)
#pragma unroll
            for (int m = 0; m < 4; ++m) {
                const int row = row0 + ai * 128 + m * 16; const size_t off = (size_t)row * D + col0;
                float q = 0.f;
#pragma unroll
                for (int bj = 0; bj < 2; ++bj) {
                    u32x2 wn[2], wx[2];
#pragma unroll
                    for (int n = 0; n < 2; ++n) {
                        const f32x4 xv = *(const f32x4*)(xi + off + bj * 128 + n * 16);
                        const f32x4 v = xv + gt[bj][n] * acc[ai][bj][m][n];
                        if (WITH_A2 && x1b) { wx[n].x = cvt_pk_bf16(v[0], v[1]); wx[n].y = cvt_pk_bf16(v[2], v[3]); }
                        else *(f32x4*)(xo + off + bj * 128 + n * 16) = v;
                        q += (v[0] * v[0] + v[1] * v[1]) + (v[2] * v[2] + v[3] * v[3]);
                        if (WITH_A2) { const f32x4 a = v * sc[bj][n]; wn[n].x = cvt_pk_bf16(a[0], a[1]); wn[n].y = cvt_pk_bf16(a[2], a[3]); }
                    }
                    if (WITH_A2 && x1b) {
                        const auto rx = __builtin_amdgcn_permlane16_swap(wx[0].x, wx[1].x, false, false), ry = __builtin_amdgcn_permlane16_swap(wx[0].y, wx[1].y, false, false);
                        *(u32x4*)(x1b + off + bj * 128 + ((fq & 1) ? 12 : 0)) = (u32x4){rx[0], ry[0], rx[1], ry[1]};
                    }
                    if (WITH_A2) {
                        const auto rx = __builtin_amdgcn_permlane16_swap(wn[0].x, wn[1].x, false, false), ry = __builtin_amdgcn_permlane16_swap(wn[0].y, wn[1].y, false, false);
                        const u32x4 w16 = (u32x4){rx[0], ry[0], rx[1], ry[1]};
                        const int cofs = (fq & 1) ? 16 + 4 * (fq - 1) - 4 * fq : 0;
                        *(u32x4*)(a2 + off + bj * 128 + cofs) = w16;
                    }
                }
                q += __shfl_xor(q, 16); q += __shfl_xor(q, 32);
                if (fq == 0) ss[(size_t)row * 16 + u.pn * 4 + wc] = q;
            }
    }
};
struct EpiTail {
    static constexpr bool PERM = false, APERM = false;
    float* xio; const float* mod; const float* gf; float* xbuf; unsigned* cnt; const bf16_t* x1b;
    __device__ __forceinline__ bool keep(const Unit&) const { return false; }
    __device__ __forceinline__ void operator()(f32x4 (&acc)[2][2][4][2], const Unit& u, int wr, int wc, int fr, int fq, LAS unsigned char* lds) const {
        const int b = (u.pm * 256) >> 12, tidx = tid_opaque();
        const int row0 = u.pm * 256 + wr * 64 + fr, col0 = u.pn * 256 + wc * 32 + 4 * fq;
        LAS float* P = (LAS float*)(lds + LDS_HALO);
        LAS float* S = (LAS float*)(lds + LDS_HALO + 4096);
        {
            f32x4 gt[2][2];
#pragma unroll
            for (int bj = 0; bj < 2; ++bj)
#pragma unroll
                for (int n = 0; n < 2; ++n) gt[bj][n] = *(const f32x4*)(mod + b * NADA + 5 * D + col0 + bj * 128 + n * 16);
#pragma unroll
            for (int ai = 0; ai < 2; ++ai)
#pragma unroll
                for (int m = 0; m < 4; ++m) {
                    const size_t off = (size_t)(row0 + ai * 128 + m * 16) * D + col0;
                    float q = 0.f;
#pragma unroll
                    for (int bj = 0; bj < 2; ++bj) {
                        const u32x4 L = *(const u32x4*)(x1b + off + bj * 128 + ((fq & 1) ? 12 : 0));
                        const auto rx = __builtin_amdgcn_permlane16_swap(L.x, L.z, false, false), ry = __builtin_amdgcn_permlane16_swap(L.y, L.w, false, false);
#pragma unroll
                        for (int n = 0; n < 2; ++n) {
                            const f32x4 xv = (f32x4){bf_lo(rx[n]), bf_hi(rx[n]), bf_lo(ry[n]), bf_hi(ry[n])};
                            const f32x4 v = xv + gt[bj][n] * acc[ai][bj][m][n];
                            acc[ai][bj][m][n] = v;
                            q += (v[0] * v[0] + v[1] * v[1]) + (v[2] * v[2] + v[3] * v[3]);
                        }
                    }
                    q += __shfl_xor(q, 16); q += __shfl_xor(q, 32);
                    if (fq == 0) P[(ai * 128 + wr * 64 + m * 16 + fr) * 4 + wc] = q;
                    asm volatile("" ::: "memory");
                }
        }
        asm volatile("s_waitcnt lgkmcnt(0)" ::: "memory"); __builtin_amdgcn_s_barrier(); asm volatile("" ::: "memory");
        if (tidx < 256) { const f32x4 p = *(const LAS f32x4*)(P + tidx * 4);
            __hip_atomic_store(xbuf + (size_t)(u.pm * 256 + tidx) * 4 + u.pn, (p[0] + p[1]) + (p[2] + p[3]), __ATOMIC_RELAXED, __HIP_MEMORY_SCOPE_AGENT); }
        asm volatile("s_waitcnt vmcnt(0)" ::: "memory"); __builtin_amdgcn_s_barrier(); asm volatile("" ::: "memory");
        if (tidx < 64) {
            if (tidx == 0) __hip_atomic_fetch_add(cnt + 64 * u.pm, 1u, __ATOMIC_RELAXED, __HIP_MEMORY_SCOPE_AGENT);
            unsigned sp = 0;
            while ((unsigned)__builtin_amdgcn_readfirstlane(__hip_atomic_load(cnt + 64 * u.pm, __ATOMIC_RELAXED, __HIP_MEMORY_SCOPE_AGENT)) < 4u) { __builtin_amdgcn_s_sleep(2); if (++sp > (1u << 22)) break; }
            __builtin_amdgcn_fence(__ATOMIC_ACQUIRE, "agent");
            asm volatile("s_waitcnt vmcnt(0)" ::: "memory");
        }
        __builtin_amdgcn_s_barrier(); asm volatile("" ::: "memory");
        if (tidx < 256) { const float* xp = xbuf + (size_t)(u.pm * 256 + tidx) * 4; float t = 0.f;
#pragma unroll
            for (int j = 0; j < 4; ++j) t += __hip_atomic_load(xp + j, __ATOMIC_RELAXED, __HIP_MEMORY_SCOPE_AGENT);
            S[tidx] = __builtin_amdgcn_rsqf(t * (1.0f / D) + EPS); }
        asm volatile("s_waitcnt vmcnt(0) lgkmcnt(0)" ::: "memory"); __builtin_amdgcn_s_barrier(); asm volatile("" ::: "memory");
        f32x4 gv[2][2];
#pragma unroll
        for (int bj = 0; bj < 2; ++bj)
#pragma unroll
            for (int n = 0; n < 2; ++n) gv[bj][n] = *(const f32x4*)(gf + col0 + bj * 128 + n * 16);
#pragma unroll
        for (int ai = 0; ai < 2; ++ai)
#pragma unroll
            for (int m = 0; m < 4; ++m) {
                const float rstd = S[ai * 128 + wr * 64 + m * 16 + fr];
                const size_t off = (size_t)(row0 + ai * 128 + m * 16) * D + col0;
#pragma unroll
                for (int bj = 0; bj < 2; ++bj)
#pragma unroll
                    for (int n = 0; n < 2; ++n) *(f32x4*)(xio + off + bj * 128 + n * 16) = acc[ai][bj][m][n] * rstd * gv[bj][n];
            }
    }
};
template <int CTRL> __device__ __forceinline__ float dpp_old(float old, float v) { return __int_as_float(__builtin_amdgcn_update_dpp(__float_as_int(old), __float_as_int(v), CTRL, 0xf, 0xf, false)); }
template <int CTRL> __device__ __forceinline__ float dpp_ror(float v) { return __int_as_float(__builtin_amdgcn_update_dpp(0, __float_as_int(v), CTRL, 0xf, 0xf, false)); }
struct Epi4 {
    static constexpr bool PERM = true, APERM = true;
    const float* ss2; const float* cb; const float* cw; bf16_t* F; int pre;
    __device__ __forceinline__ bool keep(const Unit&) const { return false; }
    __device__ __forceinline__ void operator()(f32x4 (&acc)[2][2][4][2], const Unit& u, int wr, int wc, int fr, int fq, LAS unsigned char* lds) const {
        const int grow0 = u.pm * MT4 - 2;
        LAS float* hal = (LAS float*)(lds + LDS_HALO);
        LAS float* rsT = (LAS float*)(lds + LDS_HALO + 8192) + (pre ? u.ord * 256 : 0);
        LAS int* infT = (LAS int*)(lds + LDS_HALO + 8192 + 6144);
        const int s0 = grow0 & (SEQ - 1);
        const bool fast = grow0 >= 0 && s0 >= 2 && s0 + 255 < SEQ && grow0 + 255 < M;
        if (pre == 0 || !fast) {
            const int tidx = tid_opaque();
            if (tidx < 256) {
                const int lr = tidx, gr = grow0 + lr, grc = gr < 0 ? 0 : (gr > M - 1 ? M - 1 : gr);
                if (pre == 0) { const f32x4* p = (const f32x4*)(ss2 + (size_t)grc * 16);
                    const f32x4 st = (p[0] + p[1]) + (p[2] + p[3]);
                    rsT[lr] = __builtin_amdgcn_rsqf(((st[0] + st[1]) + (st[2] + st[3])) * (1.0f / D) + EPS); }
                const int sq = grc & (SEQ - 1), b = grc >> 12, sidx = sq < 2 ? sq : 2;
                infT[lr] = (sidx * 4 + b) | (sq >= 1 ? 16 : 0) | (sq >= 2 ? 32 : 0) | ((lr >= 2 && gr < M) ? 64 : 0);
            }
            asm volatile("s_waitcnt lgkmcnt(0)" ::: "memory"); __builtin_amdgcn_s_barrier(); asm volatile("" ::: "memory");
        }
#pragma unroll
        for (int ai = 0; ai < 2; ++ai)
#pragma unroll
            for (int m = 0; m < 4; ++m) {
                const float rstd = rsT[ai * 128 + wr * 64 + 4 * fr + m];
#pragma unroll
                for (int bj = 0; bj < 2; ++bj)
#pragma unroll
                    for (int n = 0; n < 2; ++n) acc[ai][bj][m][n] *= rstd;
            }
        const int ccol = wc * 32 + 8 * fq;
        if (fr == 15) {
#pragma unroll
            for (int ai = 0; ai < 2; ++ai)
#pragma unroll
                for (int bj = 0; bj < 2; ++bj)
#pragma unroll
                    for (int n = 0; n < 2; ++n) {
                        *(LAS f32x4*)(hal + ((ai * 2 + wr) * 2 + 0) * 256 + bj * 128 + ccol + 4 * n) = acc[ai][bj][2][n];
                        *(LAS f32x4*)(hal + ((ai * 2 + wr) * 2 + 1) * 256 + bj * 128 + ccol + 4 * n) = acc[ai][bj][3][n];
                    }
        }
        asm volatile("s_waitcnt lgkmcnt(0)" ::: "memory"); __builtin_amdgcn_s_barrier(); asm volatile("" ::: "memory");
        if (fast) conv<true>(acc, u, wr, wc, fr, fq, hal, infT, grow0);
        else conv<false>(acc, u, wr, wc, fr, fq, hal, infT, grow0);
    }
    template <bool FAST> __device__ __forceinline__ void conv(f32x4 (&acc)[2][2][4][2], const Unit& u, int wr, int wc, int fr, int fq, LAS float* hal, LAS int* infT, int grow0) const {
        const int ccol = wc * 32 + 8 * fq;
        const int ncol0 = u.pn * 256 + ccol;
        const int cidx = 8 + (grow0 >> 12);
        u32x2 pk0[2][4];
#pragma unroll
        for (int n = 0; n < 2; ++n) {
            f32x4 w0[2], w1[2], w2[2], cbc[2];
#pragma unroll
            for (int bj = 0; bj < 2; ++bj) { const int c = ncol0 + bj * 128 + 4 * n; w0[bj] = *(const f32x4*)(cw + c); w1[bj] = *(const f32x4*)(cw + NUP + c); w2[bj] = *(const f32x4*)(cw + 2 * NUP + c);
                if (FAST) cbc[bj] = *(const f32x4*)(cb + (size_t)cidx * NUP + c); }
#pragma unroll
            for (int ai = 0; ai < 2; ++ai) {
                const int grp = ai * 2 + wr;
                f32x4 P3[2], P2[2];
#pragma unroll
                for (int bj = 0; bj < 2; ++bj) {
                    f32x4 c1, c2;
                    if (grp > 0) { c1 = *(const LAS f32x4*)(hal + ((grp - 1) * 2 + 1) * 256 + bj * 128 + ccol + 4 * n); c2 = *(const LAS f32x4*)(hal + ((grp - 1) * 2 + 0) * 256 + bj * 128 + ccol + 4 * n); }
                    else { c1 = (f32x4){0.f, 0.f, 0.f, 0.f}; c2 = (f32x4){0.f, 0.f, 0.f, 0.f}; }
#pragma unroll
                    for (int j = 0; j < 4; ++j) { P3[bj][j] = dpp_old<0x111>(c1[j], acc[ai][bj][3][n][j]); P2[bj][j] = dpp_old<0x111>(c2[j], acc[ai][bj][2][n][j]); }
                }
#pragma unroll
                for (int m = 0; m < 4; ++m) {
                    const int lr = ai * 128 + wr * 64 + 4 * fr + m;
                    int info = 0; if (!FAST) info = infT[lr];
                    f32x4 val[2];
#pragma unroll
                    for (int bj = 0; bj < 2; ++bj) {
                        const f32x4 Xm = acc[ai][bj][m][n];
                        f32x4 S1 = m == 0 ? P3[bj] : acc[ai][bj][m > 0 ? m - 1 : 0][n];
                        f32x4 S2 = m == 0 ? P2[bj] : (m == 1 ? P3[bj] : acc[ai][bj][m > 1 ? m - 2 : 0][n]);
                        f32x4 cbv;
                        if (FAST) cbv = cbc[bj];
                        else { cbv = *(const f32x4*)(cb + (size_t)(info & 15) * NUP + ncol0 + bj * 128 + 4 * n);
#pragma unroll
                            for (int j = 0; j < 4; ++j) { S1[j] = (info & 16) ? S1[j] : 0.f; S2[j] = (info & 32) ? S2[j] : 0.f; } }
                        val[bj] = cbv + w2[bj] * Xm + w1[bj] * S1 + w0[bj] * S2;
                    }
                    f32x4 f;
#pragma unroll
                    for (int j = 0; j < 4; ++j) f[j] = val[0][j] * sigmoid_f(val[0][j]) * val[1][j];
                    u32x2 w; w.x = cvt_pk_bf16(f[0], f[1]); w.y = cvt_pk_bf16(f[2], f[3]);
                    bool st = lr >= 2; if (!FAST) st = (info & 64) != 0;
                    if (n == 0) pk0[ai][m] = w;
                    else if (st) *(u32x4*)(F + (size_t)(grow0 + lr) * DFF + u.pn * 128 + ccol) = (u32x4){pk0[ai][m].x, pk0[ai][m].y, w.x, w.y};
                }
                if (!FAST) asm volatile("" ::: "memory");
            }
        }
    }
};


#define XB_TMO      128
#define XB_XCNT(j)  (256  + 64 * (j))
#define XB_XSUB(j)  (1280 + 64 * (j))
#define XB_XGEN(j)  (2304 + 64 * (j))
#define XB_TOP      3328
#define XB_TOPGEN   3392
#define XCD_BAR_WORDS 3456
#define XB_SPIN_CAP (1u << 22)
__device__ __forceinline__ unsigned xb_ld(unsigned* p)              { return __hip_atomic_load(p, __ATOMIC_RELAXED, __HIP_MEMORY_SCOPE_AGENT); }
__device__ __forceinline__ unsigned xb_add(unsigned* p, unsigned v) { return __hip_atomic_fetch_add(p, v, __ATOMIC_RELAXED, __HIP_MEMORY_SCOPE_AGENT); }
__device__ __forceinline__ unsigned xb_xcc_id() { return (unsigned)__builtin_amdgcn_s_getreg((3 << 11) | 20) & 0xFu; }
#define XB_SPIN(cond, bar) do { unsigned _sp = 0; while (cond) { __builtin_amdgcn_s_sleep(1); \
    if ((++_sp & 255u) == 0u) { if (xb_ld(&(bar)[XB_TMO])) break; if (_sp > XB_SPIN_CAP) { atomicAdd(&(bar)[XB_TMO], 1u); break; } } } } while (0)
struct XcdBarrier { unsigned* bar; unsigned x; volatile LAS unsigned* st; };
__device__ __forceinline__ XcdBarrier xcd_barrier_post(unsigned* bar, volatile LAS unsigned* st) {
    XcdBarrier b; b.bar = bar; b.x = xb_xcc_id(); b.st = st;
    if (threadIdx.x == 0) (void)xb_add(&bar[XB_XCNT(b.x)], 1u);
    return b;
}
__device__ __forceinline__ void xcd_barrier_complete(unsigned* bar, unsigned x, unsigned& nloc, unsigned& nx) {
    const unsigned G = gridDim.x * gridDim.y * gridDim.z;
    unsigned sum, cnt, mine, sp = 0u;
    for (;;) {
        sum = 0u; cnt = 0u; mine = 0u;
#pragma unroll
        for (unsigned j = 0; j < 16; ++j) { const unsigned c = xb_ld(&bar[XB_XCNT(j)]); sum += c; cnt += (c > 0u) ? 1u : 0u; mine = (j == x) ? c : mine; }
        if (sum == G) break;
        __builtin_amdgcn_s_sleep(1);
        if ((++sp & 255u) == 0u) { if (xb_ld(&bar[XB_TMO])) break; if (sp > XB_SPIN_CAP) { atomicAdd(&bar[XB_TMO], 1u); break; } }
    }
    nloc = mine > 0u ? mine : 1u; nx = cnt > 0u ? cnt : 1u;
}
__device__ __forceinline__ void xcd_barrier(const XcdBarrier& b) {
    asm volatile("s_waitcnt vmcnt(0)" ::: "memory");
    __syncthreads();
    if (threadIdx.x == 0) {
        unsigned* bar = b.bar;
        __builtin_amdgcn_s_waitcnt(0);
        unsigned nloc = b.st[0], nx = b.st[1];
        if (nloc == 0u) { xcd_barrier_complete(bar, b.x, nloc, nx); b.st[0] = nloc; b.st[1] = nx; }
        const unsigned old = xb_add(&bar[XB_XSUB(b.x)], 1u);
        const unsigned gen = old / nloc;
        if (old + 1u == (gen + 1u) * nloc) {
            __builtin_amdgcn_fence(__ATOMIC_RELEASE, "agent");
            asm volatile("s_waitcnt vmcnt(0)" ::: "memory");
            const unsigned og = xb_add(&bar[XB_TOP], 1u);
            const unsigned tg = og / nx;
            if (og + 1u == (tg + 1u) * nx) xb_add(&bar[XB_TOPGEN], 1u);
            else XB_SPIN(xb_ld(&bar[XB_TOPGEN]) == tg, bar);
            __builtin_amdgcn_fence(__ATOMIC_ACQUIRE, "agent");
            xb_add(&bar[XB_XGEN(b.x)], 1u);
            asm volatile("s_waitcnt vmcnt(0)" ::: "memory");
        } else {
            XB_SPIN(xb_ld(&bar[XB_XGEN(b.x)]) == gen, bar);
            __builtin_amdgcn_fence(__ATOMIC_ACQUIRE, "agent");
            asm volatile("s_waitcnt vmcnt(0)" ::: "memory");
        }
    }
    __syncthreads();
}


__device__ __forceinline__ void xcd_barrier_arrive(const XcdBarrier& b) {
    asm volatile("s_waitcnt vmcnt(0)" ::: "memory");
    __syncthreads();
    if (threadIdx.x == 0) {
        unsigned* bar = b.bar;
        __builtin_amdgcn_s_waitcnt(0);
        unsigned nloc = b.st[0], nx = b.st[1];
        if (nloc == 0u) { xcd_barrier_complete(bar, b.x, nloc, nx); b.st[0] = nloc; b.st[1] = nx; }
        const unsigned old = xb_add(&bar[XB_XSUB(b.x)], 1u);
        const unsigned gen = old / nloc;
        unsigned role = 0u, tg = 0u;
        if (old + 1u == (gen + 1u) * nloc) {
            __builtin_amdgcn_fence(__ATOMIC_RELEASE, "agent");
            asm volatile("s_waitcnt vmcnt(0)" ::: "memory");
            const unsigned og = xb_add(&bar[XB_TOP], 1u);
            tg = og / nx; role = 1u;
            if (og + 1u == (tg + 1u) * nx) { xb_add(&bar[XB_TOPGEN], 1u); role = 2u; }
        }
        b.st[4] = role; b.st[5] = gen; b.st[6] = tg;
    }
}
__device__ __forceinline__ void xcd_barrier_wait(const XcdBarrier& b) {
    if (threadIdx.x == 0) {
        unsigned* bar = b.bar;
        const unsigned role = b.st[4], gen = b.st[5], tg = b.st[6];
        if (role != 0u) {
            if (role == 1u) XB_SPIN(xb_ld(&bar[XB_TOPGEN]) == tg, bar);
            __builtin_amdgcn_fence(__ATOMIC_ACQUIRE, "agent");
            xb_add(&bar[XB_XGEN(b.x)], 1u);
            asm volatile("s_waitcnt vmcnt(0)" ::: "memory");
        } else {
            XB_SPIN(xb_ld(&bar[XB_XGEN(b.x)]) == gen, bar);
            __builtin_amdgcn_fence(__ATOMIC_ACQUIRE, "agent");
            asm volatile("s_waitcnt vmcnt(0)" ::: "memory");
        }
    }
    __syncthreads();
}

struct Args { const float* in[24]; float* out; unsigned char* ws; int use_cg; int pad; };

__device__ __forceinline__ void transpose_item(const float* W, int K, int N, bf16_t* WT, int dst_row0, int k0, int n0, float* scr, int lane) {
    {   f32x4 v[8];
#pragma unroll
        for (int i = 0; i < 8; ++i) v[i] = __builtin_nontemporal_load((const f32x4*)(W + (size_t)(k0 + 8 * i + (lane >> 3)) * N + n0 + (lane & 7) * 4));
#pragma unroll
        for (int i = 0; i < 8; ++i) { float* d = scr + (8 * i + (lane >> 3)) * 33 + (lane & 7) * 4; d[0] = v[i][0]; d[1] = v[i][1]; d[2] = v[i][2]; d[3] = v[i][3]; }
    }
    asm volatile("s_waitcnt lgkmcnt(0)" ::: "memory");
    const int c = lane & 7;
#pragma unroll
    for (int j = 0; j < 4; ++j) { const int n = (lane >> 3) + 8 * j; const float* s = scr + (8 * c) * 33 + n;
        u32x4 o; o.x = cvt_pk_bf16(s[0 * 33], s[1 * 33]); o.y = cvt_pk_bf16(s[2 * 33], s[3 * 33]); o.z = cvt_pk_bf16(s[4 * 33], s[5 * 33]); o.w = cvt_pk_bf16(s[6 * 33], s[7 * 33]);
        *(u32x4*)(WT + (size_t)(dst_row0 + n) * K + k0 + 8 * c) = o; }
    asm volatile("s_waitcnt lgkmcnt(0)" ::: "memory");
}
__device__ __forceinline__ void phase0(const Args& a, unsigned char* smem) {
    const int tid = tid_opaque(), lane = tid & 63, wave = tid >> 6, G = gridDim.x;
    unsigned char* ws = a.ws;
    float* sc = (float*)(smem + 72 * 1024);
    float* red = (float*)(smem + 88 * 1024);
    const float* c = a.in[1];
    for (int i = tid; i < 4 * D; i += 512) { const float v = c[i]; sc[i] = v * sigmoid_f(v); }
    __syncthreads();
    const float* w_ada = a.in[2]; const float* b_ada = a.in[3]; float* mod = (float*)(ws + WS_MOD);
    unsigned* modctr = (unsigned*)(ws + WS_CTL + 49152);
    for (int nc = blockIdx.x; nc < NADA / 24; nc += G) {
        const int n0 = nc * 24, col = lane & 31, par = lane >> 5; const bool act = col < 24;
        float a0 = 0.f, a1 = 0.f, a2 = 0.f, a3 = 0.f;
#pragma unroll 8
        for (int i = 0; i < 64; ++i) { const int k = wave * 128 + 2 * i + par; const float w = act ? __builtin_nontemporal_load(w_ada + (size_t)k * NADA + n0 + col) : 0.f;
            a0 += sc[k] * w; a1 += sc[D + k] * w; a2 += sc[2 * D + k] * w; a3 += sc[3 * D + k] * w; }
        a0 += __shfl_xor(a0, 32); a1 += __shfl_xor(a1, 32); a2 += __shfl_xor(a2, 32); a3 += __shfl_xor(a3, 32);
        if (lane < 32) { red[(wave * 4 + 0) * 32 + col] = a0; red[(wave * 4 + 1) * 32 + col] = a1; red[(wave * 4 + 2) * 32 + col] = a2; red[(wave * 4 + 3) * 32 + col] = a3; }
        __syncthreads();
        if (tid < 128) { const int b = tid >> 5, cc = tid & 31;
            if (cc < 24) { float s = b_ada[n0 + cc];
#pragma unroll
                for (int w = 0; w < 8; ++w) s += red[(w * 4 + b) * 32 + cc];
                __hip_atomic_store(mod + b * NADA + n0 + cc, s, __ATOMIC_RELAXED, __HIP_MEMORY_SCOPE_AGENT); } }
        asm volatile("s_waitcnt vmcnt(0)" ::: "memory");
        __syncthreads();
        if (tid == 0) __hip_atomic_fetch_add(modctr, 1u, __ATOMIC_RELAXED, __HIP_MEMORY_SCOPE_AGENT);
    }
    float* scr = (float*)(smem + wave * 17408);
    const int gw = blockIdx.x * 8 + wave, NGW = G * 8;
    constexpr int I_IN = 16 * 64, I_GATE = 16 * 64, I_SQ = 16 * 32, I_UP = 16 * 176, I_DN = 44 * 32, I_PC = 4 * 8 * 64;
    constexpr int NITEMS = I_IN + I_GATE + I_UP + I_PC;
    const int nj = (NITEMS - gw + NGW - 1) / NGW; const bool revo = ((wave >> 2) & 1) == 0;
    for (int jj = 0; jj < nj; ++jj) {
        const int it = gw + NGW * (revo ? nj - 1 - jj : jj);
        int r = it;
        if (r < I_IN) { const int nb = 64, kb = r / nb, n0 = (r % nb) * 32; transpose_item(a.in[5], D, 3 * D, (bf16_t*)(ws + WS_W1T), n0, kb * 64, n0, scr, lane); continue; } r -= I_IN;
        if (r < I_GATE) { const int nb = 64, kb = r / nb, n0 = (r % nb) * 32; transpose_item(a.in[15], D, 2 * D, (bf16_t*)(ws + WS_W1T), 3 * D + n0, kb * 64, n0, scr, lane); continue; } r -= I_GATE;
        if (r < I_UP) { const int nb = 176, kb = r / nb, n0 = (r % nb) * 32; const int half = n0 >= DFF ? 1 : 0, j = n0 - half * DFF;
            transpose_item(a.in[19], D, NUP, (bf16_t*)(ws + WS_WUP), (j >> 7) * 256 + half * 128 + (j & 127), kb * 64, n0, scr, lane); continue; } r -= I_UP;
        {
            const int g = r >> 9, q = r & 511, n0 = (q >> 6) * 32, k0 = (q & 63) * 16, nn = lane & 31, kh = lane >> 5;
            float* At = (float*)(smem + wave * 17408);
            { const float* Ag = a.in[5] + (size_t)k0 * (3 * D) + 2 * D + g * 256; f32x4 av[16];
#pragma unroll
              for (int i = 0; i < 16; ++i) av[i] = *(const f32x4*)(Ag + (size_t)i * (3 * D) + 4 * lane);
#pragma unroll
              for (int i = 0; i < 16; ++i) *(f32x4*)(At + i * 260 + 4 * lane) = av[i]; }
            asm volatile("s_waitcnt lgkmcnt(0)" ::: "memory");
            const float* Bp = a.in[10] + (size_t)g * 65536 + n0 + nn;
            const float* Ar = At + (kh * 8) * 260;
            float accp[8];
#pragma unroll
            for (int i = 0; i < 8; ++i) accp[i] = 0.f;
#pragma unroll 2
            for (int c0 = 0; c0 < 256; c0 += 32) {
                float bv[32];
#pragma unroll
                for (int j = 0; j < 32; ++j) bv[j] = Bp[(size_t)(c0 + j) * 256];
#pragma unroll
                for (int i = 0; i < 8; ++i)
#pragma unroll
                    for (int j = 0; j < 32; j += 4) { const f32x4 a4 = *(const f32x4*)(Ar + i * 260 + c0 + j); accp[i] += (a4[0] * bv[j] + a4[1] * bv[j + 1]) + (a4[2] * bv[j + 2] + a4[3] * bv[j + 3]); }
            }
            u32x4 o; o.x = cvt_pk_bf16(accp[0], accp[1]); o.y = cvt_pk_bf16(accp[2], accp[3]); o.z = cvt_pk_bf16(accp[4], accp[5]); o.w = cvt_pk_bf16(accp[6], accp[7]);
            *(u32x4*)((bf16_t*)(ws + WS_W1T) + (size_t)(2 * D + g * 256 + n0 + nn) * D + k0 + kh * 8) = o;
            asm volatile("s_waitcnt lgkmcnt(0)" ::: "memory");
        }
    }
    if (tid < 64) { unsigned sp = 0;
        while ((unsigned)__builtin_amdgcn_readfirstlane(__hip_atomic_load(modctr, __ATOMIC_RELAXED, __HIP_MEMORY_SCOPE_AGENT)) < (unsigned)(NADA / 24)) { __builtin_amdgcn_s_sleep(2); if (++sp > (1u << 22)) break; }
        __builtin_amdgcn_fence(__ATOMIC_ACQUIRE, "agent");
        asm volatile("s_waitcnt vmcnt(0)" ::: "memory"); }
    __syncthreads();
    const float* x = a.in[0]; const float* g1 = a.in[4]; bf16_t* H = (bf16_t*)(ws + WS_H);
    for (int rg = gw; rg < M / 8; rg += NGW) {
        const int r0 = rg * 8, b = r0 >> 12;
        f32x4 scl[4], sft[4];
#pragma unroll
        for (int j = 0; j < 4; ++j) { const int c = 4 * lane + 256 * j; scl[j] = *(const f32x4*)(g1 + c) * (*(const f32x4*)(mod + b * NADA + D + c) + 1.0f); sft[j] = *(const f32x4*)(mod + b * NADA + c); }
#pragma unroll 2
        for (int r = 0; r < 8; ++r) {
            const float* xr = x + (size_t)(r0 + r) * D + 4 * lane; f32x4 v[4]; float ss = 0.f;
#pragma unroll
            for (int j = 0; j < 4; ++j) { v[j] = __builtin_nontemporal_load((const f32x4*)(xr + 256 * j)); ss += (v[j][0] * v[j][0] + v[j][1] * v[j][1]) + (v[j][2] * v[j][2] + v[j][3] * v[j][3]); }
            const float rstd = __builtin_amdgcn_rsqf(wave_sum(ss) * (1.0f / D) + EPS);
            bf16_t* hr = H + (size_t)(r0 + r) * D + 4 * lane;
#pragma unroll
            for (int j = 0; j < 4; ++j) { const f32x4 o = v[j] * rstd * scl[j] + sft[j]; u32x2 w; w.x = cvt_pk_bf16(o[0], o[1]); w.y = cvt_pk_bf16(o[2], o[3]); *(u32x2*)(hr + 256 * j) = w; }
        }
    }
}

__device__ __forceinline__ void phase0b(const Args& a, unsigned char* smem) {
    const int tid = tid_opaque(), lane = tid & 63, wave = tid >> 6, G = gridDim.x;
    unsigned char* ws = a.ws;
    float* scr = (float*)(smem + wave * 17408);
    const int gw = blockIdx.x * 8 + wave, NGW = G * 8;
    constexpr int I_SQ = 16 * 32, I_DN = 44 * 32, NITEMS = 3 * I_SQ + I_DN;
    for (int it = gw; it < NITEMS; it += NGW) {
        int r = it;
        if (r < I_SQ) { const int kb = r / 32, n0 = (r % 32) * 32; transpose_item(a.in[13], D, D, (bf16_t*)(ws + WS_WPA), n0, kb * 64, n0, scr, lane); continue; } r -= I_SQ;
        if (r < I_SQ) { const int kb = r / 32, n0 = (r % 32) * 32; transpose_item(a.in[14], D, D, (bf16_t*)(ws + WS_WPB), n0, kb * 64, n0, scr, lane); continue; } r -= I_SQ;
        if (r < I_SQ) { const int kb = r / 32, n0 = (r % 32) * 32; transpose_item(a.in[17], D, D, (bf16_t*)(ws + WS_WOUT), n0, kb * 64, n0, scr, lane); continue; } r -= I_SQ;
        { const int kb = r / 32, n0 = (r % 32) * 32; transpose_item(a.in[22], DFF, D, (bf16_t*)(ws + WS_WDN), n0, kb * 64, n0, scr, lane); }
    }
    { const float* wsp = a.in[8]; bf16_t* o = (bf16_t*)(ws + WS_WSP);
      for (int i = blockIdx.x * 512 + tid; i < 8 * 128 * 128 / 2; i += G * 512) { const int e = 2 * i, p = (e >> 7) & 127, q = e & 127; const bool ok = (q >> 6) <= (p >> 6);
          const f32x2 v = *(const f32x2*)(wsp + e); ((unsigned*)o)[i] = ok ? cvt_pk_bf16(v.x, v.y) : 0u; } }
}

__device__ __forceinline__ void phase1(const Args& a, unsigned char* smem) {
    const int tid = tid_opaque(), lane = tid & 63, wave = tid >> 6, G = gridDim.x;
    unsigned char* ws = a.ws; const float* mod = (const float*)(ws + WS_MOD);
    const float* x = a.in[0]; const float* g1 = a.in[4]; bf16_t* H = (bf16_t*)(ws + WS_H);
    const int gw = blockIdx.x * 8 + wave, NGW = G * 8;
    float* sh2 = (float*)smem;
    for (int i = tid; i < 4 * D; i += 512) sh2[i] = mod[(i >> 10) * NADA + 3 * D + (i & 1023)];
    __syncthreads();
    const bf16_t* Wup = (const bf16_t*)(ws + WS_WUP); const float* convw = a.in[20]; const float* convb = a.in[21];
    float* cb = (float*)(ws + WS_CB); float* cw = (float*)(ws + WS_CW);
    for (int np = gw; np < NUP; np += NGW) {
        float d0 = 0.f, d1 = 0.f, d2 = 0.f, d3 = 0.f;
#pragma unroll
        for (int j = 0; j < 2; ++j) { const int k0 = 8 * lane + 512 * j; const u32x4 w = *(const u32x4*)(Wup + (size_t)np * D + k0);
#pragma unroll
            for (int e = 0; e < 4; ++e) { const float lo = bf_lo(w[e]), hi = bf_hi(w[e]); const int k = k0 + 2 * e;
                d0 += lo * sh2[k] + hi * sh2[k + 1]; d1 += lo * sh2[D + k] + hi * sh2[D + k + 1]; d2 += lo * sh2[2 * D + k] + hi * sh2[2 * D + k + 1]; d3 += lo * sh2[3 * D + k] + hi * sh2[3 * D + k + 1]; } }
        d0 = wave_sum(d0); d1 = wave_sum(d1); d2 = wave_sum(d2); d3 = wave_sum(d3);
        const int pn = np >> 8, r = np & 255, half = r >> 7, jl = r & 127, n = half * DFF + pn * 128 + jl;
        const float w0 = convw[n], w1 = convw[NUP + n], w2 = convw[2 * NUP + n], cbv = convb[n];
        if (lane < 12) { const int sidx = lane >> 2, b = lane & 3; const float sw = sidx == 0 ? w2 : (sidx == 1 ? w1 + w2 : w0 + w1 + w2); const float dv = b == 0 ? d0 : (b == 1 ? d1 : (b == 2 ? d2 : d3));
            cb[(size_t)(sidx * 4 + b) * NUP + np] = cbv + dv * sw; }
        else if (lane < 15) { const int k = lane - 12; cw[k * NUP + np] = k == 0 ? w0 : (k == 1 ? w1 : w2); }
    }
}

__device__ __forceinline__ void phase3(const Args& a, unsigned char* smem) {
    const int G = gridDim.x;
    unsigned char* ws = a.ws;
    bf16_t* U = (bf16_t*)(ws + WS_U); const bf16_t* V = (const bf16_t*)(ws + WS_V); const bf16_t* ZB = (const bf16_t*)(ws + WS_ZB); bf16_t* YB = (bf16_t*)(ws + WS_H);
    const float* vst = (const float*)(ws + WS_VST);
    const bf16_t* Wsp = (const bf16_t*)(ws + WS_WSP);
    const float* lng = a.in[6]; const float* lnb = a.in[7]; const float* bsp = a.in[9]; const float* bpool = a.in[11]; const float* pscale = a.in[12];
#ifndef REP_POOL
#define REP_POOL 1
#endif
#ifndef REP_SPAT
#define REP_SPAT 1
#endif
    for (int it0 = blockIdx.x; it0 < REP_POOL * 512 + REP_SPAT * 1024; it0 += G) {
        int it = it0 < REP_POOL * 512 ? (it0 & 511) : it0 - (REP_POOL - 1) * 512; bool do_store = true;
        if (it >= 512 + 1024) { it -= 1024; do_store = (a.use_cg == 77); }
        __syncthreads();
        const int tid = tid_opaque(), lane = tid & 63, wave = tid >> 6, wr = wave >> 2, wc = wave & 3, fr = lane & 15, fq = lane >> 4;
        if (it < 512) {
            const int tb = it >> 2, g = it & 3, m0 = tb * 128, c0 = g * 256, w = 2 << g, sqm0 = m0 & (SEQ - 1);
            bf16_t* Raw = (bf16_t*)smem;
            {   u32x4 zr[9];
#pragma unroll
                for (int j = 0; j < 9; ++j) { const int idx = tid + 512 * j, r = idx >> 5, cc = idx & 31;
                    zr[j] = (u32x4){0u, 0u, 0u, 0u};
                    if (r >= 16 || sqm0 != 0) zr[j] = *(const u32x4*)(ZB + (size_t)(m0 - 16 + r) * D + c0 + cc * 8); }
#pragma unroll
                for (int j = 0; j < 9; ++j) { const int idx = tid + 512 * j, r = idx >> 5, cc = idx & 31; *(u32x4*)(Raw + r * 264 + cc * 8) = zr[j]; }
            }
            const int cc = tid & 31, strip = tid >> 5, lr0 = strip * 8;
            const f32x4 bp0 = *(const f32x4*)(bpool + c0 + cc * 8), bp1 = *(const f32x4*)(bpool + c0 + cc * 8 + 4), ps0 = *(const f32x4*)(pscale + c0 + cc * 8), ps1 = *(const f32x4*)(pscale + c0 + cc * 8 + 4);
            __syncthreads();
            { const bf16_t* rp = Raw + (lr0 + 16) * 264 + cc * 8;
              float sum[8];
#pragma unroll
              for (int e = 0; e < 8; ++e) sum[e] = 0.f;
              for (int j = 1; j < w; ++j) { const u32x4 z = *(const u32x4*)(rp - j * 264);
#pragma unroll
                  for (int e = 0; e < 4; ++e) { sum[2 * e] += bf_lo(z[e]); sum[2 * e + 1] += bf_hi(z[e]); } }
#pragma unroll
              for (int i = 0; i < 8; ++i) {
                  const u32x4 z = *(const u32x4*)(rp + i * 264); const int sq = sqm0 + lr0 + i; const float inv = 1.0f / (float)(sq + 1 < w ? sq + 1 : w);
                  float o[8];
#pragma unroll
                  for (int e = 0; e < 4; ++e) { const float lo = bf_lo(z[e]), hi = bf_hi(z[e]); sum[2 * e] += lo; sum[2 * e + 1] += hi; o[2 * e] = sum[2 * e] * inv - lo; o[2 * e + 1] = sum[2 * e + 1] * inv - hi; }
#pragma unroll
                  for (int e = 0; e < 8; ++e) o[e] = (o[e] + (e < 4 ? bp0[e & 3] : bp1[e & 3])) * (e < 4 ? ps0[e & 3] : ps1[e & 3]);
                  u32x4 pw; pw.x = cvt_pk_bf16(o[0], o[1]); pw.y = cvt_pk_bf16(o[2], o[3]); pw.z = cvt_pk_bf16(o[4], o[5]); pw.w = cvt_pk_bf16(o[6], o[7]);
                  *(u32x4*)(YB + (size_t)(m0 + lr0 + i) * D + c0 + cc * 8) = pw;
                  const u32x4 zo = *(const u32x4*)(rp + (i - (w - 1)) * 264);
#pragma unroll
                  for (int e = 0; e < 4; ++e) { sum[2 * e] -= bf_lo(zo[e]); sum[2 * e + 1] -= bf_hi(zo[e]); }
              } }
        } else {
            const int si = it - 512, nb = si >> 3, g = si & 7, m0 = nb * 128, c0 = g * 128;
            bf16_t* vT = (bf16_t*)smem;
            float* st = (float*)(smem + 36864);
            const int kmax = wr == 0 ? 2 : 4;
            const bf16_t* Ap = Wsp + (size_t)g * 16384 + (size_t)(64 * wr + fr) * 128 + 8 * fq;
            bf16x8 Af[4][4];
#pragma unroll
            for (int ks = 0; ks < 4; ++ks)
#pragma unroll
                for (int m = 0; m < 4; ++m) Af[ks][m] = (ks < kmax) ? *(const bf16x8*)(Ap + m * 16 * 128 + ks * 32) : (bf16x8){0, 0, 0, 0, 0, 0, 0, 0};
            const int d0 = (tid & 15) * 8;
            u32x4 zv[4];
#pragma unroll
            for (int j = 0; j < 4; ++j) zv[j] = *(const u32x4*)(V + (size_t)(m0 + ((tid + 512 * j) >> 4)) * D + c0 + d0);
            u32x4 uu[4];
#pragma unroll
            for (int m = 0; m < 4; ++m) uu[m] = *(const u32x4*)(U + (size_t)(m0 + 64 * wr + 16 * m + fr) * D + c0 + 32 * wc + 8 * fq);
            const f32x4 ga = *(const f32x4*)(lng + c0 + d0), gb2 = *(const f32x4*)(lng + c0 + d0 + 4), ba = *(const f32x4*)(lnb + c0 + d0), bb = *(const f32x4*)(lnb + c0 + d0 + 4);
            if (tid < 128) { const f32x4* p = (const f32x4*)(vst + (size_t)(m0 + tid) * 32); float sm = 0.f, q = 0.f;
#pragma unroll
                for (int j = 0; j < 8; ++j) { const f32x4 t = p[j]; sm += t[0] + t[2]; q += t[1] + t[3]; }
                const float mu = sm * (1.0f / D), var = q * (1.0f / D) - mu * mu; st[2 * tid] = mu; st[2 * tid + 1] = __builtin_amdgcn_rsqf(var + EPS); }
            __syncthreads();
#pragma unroll
            for (int j = 0; j < 4; ++j) { const int q = (tid + 512 * j) >> 4;
                const u32x4 z = zv[j]; const float mu = st[2 * q], rs = st[2 * q + 1];
                float o[8];
#pragma unroll
                for (int e = 0; e < 4; ++e) { o[2 * e] = bf_lo(z[e]); o[2 * e + 1] = bf_hi(z[e]); }
#pragma unroll
                for (int e = 0; e < 8; ++e) { const float gg = e < 4 ? ga[e & 3] : gb2[e & 3], bbv = e < 4 ? ba[e & 3] : bb[e & 3]; const float y = (o[e] - mu) * rs * gg + bbv;
                    const int d = d0 + e, sw = ((d >> 3) ^ d) & 15;
                    vT[d * 128 + ((((q >> 3) ^ sw) << 3) | (q & 7))] = (bf16_t)(cvt_pk_bf16(y, 0.f) & 0xffffu); } }
            __syncthreads();
            f32x4 acc[4][2];
#pragma unroll
            for (int m = 0; m < 4; ++m)
#pragma unroll
                for (int n = 0; n < 2; ++n) acc[m][n] = (f32x4){0.f, 0.f, 0.f, 0.f};
#pragma unroll
            for (int ks = 0; ks < 4; ++ks) {
                if (ks < kmax) {
                    bf16x8 Bf[2];
#pragma unroll
                    for (int n = 0; n < 2; ++n) { const int d = 32 * wc + 8 * (fr >> 2) + 4 * n + (fr & 3), sw = ((d >> 3) ^ d) & 15; Bf[n] = *(const bf16x8*)(vT + d * 128 + (((ks * 4 + fq) ^ sw) << 3)); }
#pragma unroll
                    for (int m = 0; m < 4; ++m)
#pragma unroll
                        for (int n = 0; n < 2; ++n) acc[m][n] = __builtin_amdgcn_mfma_f32_16x16x32_bf16(Bf[n], Af[ks][m], acc[m][n], 0, 0, 0);
                }
            }
#pragma unroll
            for (int m = 0; m < 4; ++m) { const int p = 64 * wr + 16 * m + fr; const float bs = bsp[g * 128 + p];
                { bf16_t* up = U + (size_t)(m0 + p) * D + c0 + 32 * wc + 8 * fq; const u32x4 uv = uu[m];
                    u32x4 o;
                    o.x = cvt_pk_bf16(bf_lo(uv.x) * (acc[m][0][0] + bs), bf_hi(uv.x) * (acc[m][0][1] + bs)); o.y = cvt_pk_bf16(bf_lo(uv.y) * (acc[m][0][2] + bs), bf_hi(uv.y) * (acc[m][0][3] + bs));
                    o.z = cvt_pk_bf16(bf_lo(uv.z) * (acc[m][1][0] + bs), bf_hi(uv.z) * (acc[m][1][1] + bs)); o.w = cvt_pk_bf16(bf_lo(uv.w) * (acc[m][1][2] + bs), bf_hi(uv.w) * (acc[m][1][3] + bs));
                    if (do_store) *(u32x4*)up = o; } }
        }
    }
}

__device__ __forceinline__ void phase9(const Args& a) {
    const int tid = tid_opaque(), lane = tid & 63, wave = tid >> 6, G = gridDim.x;
    const float* ss3 = (const float*)(a.ws + WS_SS3); const float* gf = a.in[23]; float* out = a.out;
    const int gw = blockIdx.x * 8 + wave, NGW = G * 8;
    f32x4 gv[4];
#pragma unroll
    for (int j = 0; j < 4; ++j) gv[j] = *(const f32x4*)(gf + 4 * lane + 256 * j);
    for (int row0 = gw * 4; row0 < M; row0 += NGW * 4) {
        f32x4 v[4][4]; float rstd[4];
#pragma unroll
        for (int r = 0; r < 4; ++r) {
            const f32x4* p = (const f32x4*)(ss3 + (size_t)(row0 + r) * 16); const f32x4 st = (p[0] + p[1]) + (p[2] + p[3]);
            rstd[r] = __builtin_amdgcn_rsqf(((st[0] + st[1]) + (st[2] + st[3])) * (1.0f / D) + EPS);
            const float* xr = out + (size_t)(row0 + r) * D + 4 * lane;
#pragma unroll
            for (int j = 0; j < 4; ++j) v[r][j] = *(const f32x4*)(xr + 256 * j);
        }
#pragma unroll
        for (int r = 0; r < 4; ++r) { float* xr = out + (size_t)(row0 + r) * D + 4 * lane;
#pragma unroll
            for (int j = 0; j < 4; ++j) *(f32x4*)(xr + 256 * j) = v[r][j] * rstd[r] * gv[j]; }
    }
}

__global__ void __launch_bounds__(512, 2) fwd_megakernel(Args a) {
    extern __shared__ __attribute__((aligned(16))) unsigned char smem[];
    cg::grid_group grid = cg::this_grid();
    LAS unsigned char* lds = (LAS unsigned char*)smem;
    unsigned char* ws = a.ws;
    const int G = gridDim.x, bx = blockIdx.x;

#ifndef PH_MASK
#define PH_MASK 0xFFFF
#endif
#ifndef REP_P0
#define REP_P0 1
#endif
#ifndef REP_P1
#define REP_P1 1
#endif
#ifndef REP_G1
#define REP_G1 1
#endif
#ifndef REP_G2
#define REP_G2 1
#endif
#ifndef REP_G3
#define REP_G3 1
#endif
#ifndef REP_G4
#define REP_G4 1
#endif
#ifndef REP_SYNC
#define REP_SYNC 1
#endif
#define GSYNC() do { for (int _r = 0; _r < REP_SYNC; ++_r) { if (a.use_cg) grid.sync(); else xcd_barrier(xbar); } } while (0)
    volatile LAS unsigned* xst = (volatile LAS unsigned*)(lds + LDS_BYTES - 64);
    if (threadIdx.x < 2) xst[threadIdx.x] = 0u;
    __syncthreads();
    const XcdBarrier xbar = xcd_barrier_post((unsigned*)(ws + WS_CTL), xst);
    for (int rep = 0; rep < REP_P0; ++rep) { phase0(a, smem); __syncthreads(); }
    if (a.use_cg) { phase0b(a, smem); __syncthreads(); grid.sync(); }
    else { xcd_barrier_arrive(xbar); phase0b(a, smem); xcd_barrier_wait(xbar); }
    for (int rep = 0; rep < REP_G1; ++rep) {
        pg8::Gemm g; g.A0 = g.A1 = (const bf16_t*)(ws + WS_H); g.B0 = g.B1 = (const bf16_t*)(ws + WS_W1T); g.K = D; g.mstride = 256;
        pg8::TileOrder S; S.init(M / 256, N1 / 256, G, bx, 0);
        Epi1 E{(bf16_t*)(ws + WS_U), (bf16_t*)(ws + WS_V), (bf16_t*)(ws + WS_ZB), (bf16_t*)(ws + WS_G), a.in[16], (float*)(ws + WS_VST)};
        pg8::gemm_phase(lds, g, S, E);
    }
    if (a.use_cg) { grid.sync(); phase1(a, smem); __syncthreads(); }
    else { xcd_barrier_arrive(xbar); phase1(a, smem); xcd_barrier_wait(xbar); }
    phase3(a, smem);
    GSYNC();
    for (int rep = 0; rep < REP_G2; ++rep) {
        pg8::Gemm g; g.A0 = (const bf16_t*)(ws + WS_U); g.A1 = (const bf16_t*)(ws + WS_H); g.B0 = (const bf16_t*)(ws + WS_WPA); g.B1 = (const bf16_t*)(ws + WS_WPB); g.K = D; g.mstride = 256;
        pg8::TileOrder S; S.init(M / 256, D / 256, G, bx, 1);
        Epi2 E{(const bf16_t*)(ws + WS_G), (bf16_t*)(ws + WS_V)};
        pg8::gemm_phase(lds, g, S, E);
    }
    GSYNC();
    for (int rep = 0; rep < REP_G3; ++rep) {
        pg8::Gemm g; g.A0 = g.A1 = (const bf16_t*)(ws + WS_V); g.B0 = g.B1 = (const bf16_t*)(ws + WS_WOUT); g.K = D; g.mstride = 256;
        pg8::TileOrder S; S.init(M / 256, D / 256, G, bx, 0);
        EpiRes<true> E{a.in[0], a.out, (bf16_t*)(ws + WS_H), (const float*)(ws + WS_MOD), 2 * D, a.in[18], (float*)(ws + WS_SS2), G == (M / 256) * (D / 256) ? (bf16_t*)(ws + WS_G) : nullptr};
        pg8::gemm_phase(lds, g, S, E);
    }
    GSYNC();
    for (int rep = 0; rep < REP_G4; ++rep) {
        pg8::Gemm g; g.A0 = g.A1 = (const bf16_t*)(ws + WS_H) - (size_t)2 * D; g.B0 = g.B1 = (const bf16_t*)(ws + WS_WUP); g.K = D; g.mstride = MT4;
        pg8::TileOrder S; S.init(NM4, NUP / 256, G, bx, 0);
        int pre = 0;
        { Unit pu; if (!S.next(6, pu)) {
              const int t = tid_opaque(); LAS float* rsBig = (LAS float*)(lds + LDS_HALO + 8192);
              if (t < 256) {
#pragma unroll
                  for (int i = 0; i < 6; ++i) if (S.next(i, pu)) { int gr = pu.pm * MT4 - 2 + t; gr = gr < 0 ? 0 : (gr > M - 1 ? M - 1 : gr);
                      const f32x4* p = (const f32x4*)((const float*)(ws + WS_SS2) + (size_t)gr * 16); const f32x4 st = (p[0] + p[1]) + (p[2] + p[3]);
                      rsBig[i * 256 + t] = __builtin_amdgcn_rsqf(((st[0] + st[1]) + (st[2] + st[3])) * (1.0f / D) + EPS); } }
              pre = 6; __syncthreads(); } }
        Epi4 E{(const float*)(ws + WS_SS2), (const float*)(ws + WS_CB), (const float*)(ws + WS_CW), (bf16_t*)(ws + WS_F), pre};
        pg8::gemm_phase(lds, g, S, E);
    }
    GSYNC();
    if (G == (M / 256) * (D / 256)) {
        pg8::Gemm g; g.A0 = g.A1 = (const bf16_t*)(ws + WS_F); g.B0 = g.B1 = (const bf16_t*)(ws + WS_WDN); g.K = DFF; g.mstride = 256;
        pg8::TileOrder S; S.init(M / 256, D / 256, G, bx, 0);
        EpiTail E{a.out, (const float*)(ws + WS_MOD), a.in[23], (float*)(ws + WS_VST), (unsigned*)(ws + WS_CTL + 16384), (const bf16_t*)(ws + WS_G)};
        pg8::gemm_phase(lds, g, S, E);
        return;
    }
    {
        pg8::Gemm g; g.A0 = g.A1 = (const bf16_t*)(ws + WS_F); g.B0 = g.B1 = (const bf16_t*)(ws + WS_WDN); g.K = DFF; g.mstride = 256;
        pg8::TileOrder S; S.init(M / 256, D / 256, G, bx, 0);
        EpiRes<false> E{a.out, a.out, nullptr, (const float*)(ws + WS_MOD), 5 * D, nullptr, (float*)(ws + WS_SS3), nullptr};
        pg8::gemm_phase(lds, g, S, E);
    }
    GSYNC();
    phase9(a);
}

extern "C" void kernel_launch(void* const* d_in, const int* in_sizes, int n_in, void* d_out, int out_size, void* d_ws, size_t ws_size, hipStream_t stream) {
    static int grid = 0;
    if (grid == 0) {
        int dev = 0, cus = 0, per_cu = 0;
        hipGetDevice(&dev);
        hipDeviceGetAttribute(&cus, hipDeviceAttributeMultiprocessorCount, dev);
        hipFuncSetAttribute((const void*)fwd_megakernel, hipFuncAttributeMaxDynamicSharedMemorySize, LDS_BYTES);
        hipOccupancyMaxActiveBlocksPerMultiprocessor(&per_cu, (const void*)fwd_megakernel, 512, LDS_BYTES);
        if (per_cu < 1) { fprintf(stderr, "kernel_launch: occupancy query says %d blocks per CU\n", per_cu); per_cu = 1; }
        grid = cus * per_cu;
    }
    if (hipMemsetAsync((char*)d_ws + WS_CTL, 0, CTL_BYTES, stream) != hipSuccess) fprintf(stderr, "kernel_launch: memset of the barrier words failed\n");
    Args a{};
    for (int i = 0; i < 24; ++i) a.in[i] = (const float*)d_in[i];
    a.out = (float*)d_out; a.ws = (unsigned char*)d_ws;
    void* args[] = {&a};
    hipError_t e = hipLaunchCooperativeKernel((const void*)fwd_megakernel, dim3(grid), dim3(512), args, LDS_BYTES, stream);
    if (e != hipSuccess) fprintf(stderr, "cooperative launch failed: %s (grid %d)\n", hipGetErrorString(e), grid);
}
```
